# Optimizing an MI355X kernel written in HIP

```python
import math
import jax, jax.numpy as jnp
from jax import lax
import numpy as np

D_MODEL = 2048
BATCH = 16
SEQ = 2048
DEPTH = 2
DEC_BATCH = 2
DEC_SEQ = 8192
PAST_LEN = 128

GRID_W = 64
F_GROUPS = 4
F_GROUP_DIM = 128
F_W = F_GROUPS * F_GROUP_DIM
C_W = 512
CONV_K = 31
CONV_PAD = CONV_K // 2
N_HEADS = 8
HEAD_DIM = 128
A_W = N_HEADS * HEAD_DIM
WIN_R = 8
WIN_C = 16
KEY_COLS = 2 * WIN_C
N_COL_BLOCKS = GRID_W // WIN_C
N_BRANCH = 3
OFF_F = 0
OFF_CA = OFF_F + F_W
OFF_CG = OFF_CA + C_W
OFF_Q = OFF_CG + C_W
OFF_K = OFF_Q + A_W
OFF_V = OFF_K + A_W
OFF_G = OFF_V + A_W
IN_COLS = OFF_G + N_BRANCH * D_MODEL
D_FF = 4 * D_MODEL
EPS = 1e-6
NEG_INF = -1e30

kernel_name = 'hybrid_fnet_conformer_natten_encoder'


def rms_norm(x, g):
    xf = x.astype(jnp.float32)
    y = xf * lax.rsqrt(jnp.mean(xf * xf, axis=-1, keepdims=True) + EPS)
    return (y * g.astype(jnp.float32)).astype(x.dtype)


def layer_norm(x, g, b):
    xf = x.astype(jnp.float32)
    mu = jnp.mean(xf, axis=-1, keepdims=True)
    xc = xf - mu
    y = xc * lax.rsqrt(jnp.mean(xc * xc, axis=-1, keepdims=True) + EPS)
    return (y * g.astype(jnp.float32) + b.astype(jnp.float32)).astype(x.dtype)


def fourier_mix(u):
    b, s, _ = u.shape
    uf = u.astype(jnp.float32).reshape(b, s, F_GROUPS, F_GROUP_DIM)
    y = jnp.fft.fft2(uf, axes=(1, 3), norm='ortho').real
    return y.reshape(b, s, F_W).astype(u.dtype)


def conv_module(a, g, dw, db, ln_g, ln_b):
    u = a * jax.nn.sigmoid(g)
    y = lax.conv_general_dilated(
        u, dw[:, None, :].astype(u.dtype), window_strides=(1,),
        padding=[(CONV_PAD, CONV_PAD)],
        dimension_numbers=('NWC', 'WIO', 'NWC'),
        feature_group_count=C_W) + db
    return jax.nn.silu(layer_norm(y, ln_g, ln_b))


def na_column_tables():
    col_starts = tuple(min(max(j * WIN_C - WIN_C // 2, 0), GRID_W - KEY_COLS)
                       for j in range(N_COL_BLOCKS))
    j = np.arange(N_COL_BLOCKS)[:, None, None]
    qi = np.arange(WIN_C)[None, :, None]
    kk = np.arange(KEY_COLS)[None, None, :]
    c = j * WIN_C + qi
    start = np.clip(c - WIN_C // 2, 0, GRID_W - WIN_C)
    kc = np.asarray(col_starts)[:, None, None] + kk
    mask = (kc >= start) & (kc < start + WIN_C)
    dc = np.clip(kc - c, -(WIN_C - 1), WIN_C - 1) + (WIN_C - 1)
    return col_starts, mask[:, :, None, :], dc[:, :, None, :].astype(np.int32)


def neighbourhood_attention(q, k, v, rpb):
    b, s = q.shape[0], q.shape[1]
    rows = s // GRID_W
    kr = min(WIN_R, rows)
    scale = 1.0 / math.sqrt(HEAD_DIM)
    qg = q.reshape(b, rows, GRID_W, N_HEADS, HEAD_DIM)
    kg = k.reshape(b, rows, GRID_W, N_HEADS, HEAD_DIM)
    vg = v.reshape(b, rows, GRID_W, N_HEADS, HEAD_DIM)
    col_starts, mask, dc_idx = na_column_tables()

    def row_step(r):
        rs = jnp.clip(r - kr // 2, 0, rows - kr)
        k_rows = lax.dynamic_slice_in_dim(kg, rs, kr, axis=1)
        v_rows = lax.dynamic_slice_in_dim(vg, rs, kr, axis=1)
        kb = jnp.stack([k_rows[:, :, c0:c0 + KEY_COLS] for c0 in col_starts], axis=1)
        vb = jnp.stack([v_rows[:, :, c0:c0 + KEY_COLS] for c0 in col_starts], axis=1)
        qr = lax.dynamic_index_in_dim(qg, r, axis=1, keepdims=False)
        qr = qr.reshape(b, N_COL_BLOCKS, WIN_C, N_HEADS, HEAD_DIM)
        sc = jnp.einsum('bjqhd,bjrkhd->bhjqrk', qr, kb).astype(jnp.float32) * scale
        dr_idx = rs + jnp.arange(kr) - r + (WIN_R - 1)
        bias = rpb[:, dr_idx[None, None, :, None], dc_idx]
        sc = jnp.where(mask, sc + bias.astype(jnp.float32)[None], NEG_INF)
        p = jax.nn.softmax(sc, axis=(-2, -1))
        o = jnp.einsum('bhjqrk,bjrkhd->bjqhd', p.astype(vb.dtype), vb)
        return o.reshape(b, GRID_W, A_W)

    out = lax.map(row_step, jnp.arange(rows))
    return out.transpose(1, 0, 2, 3).reshape(b, s, A_W)


def encoder_layer(x, n1, w_in, b_g, w_f, dw, db, ln_g, ln_b, w_c, qg_, kg_, rpb, w_a, w_o, n2, w1, w2):
    b, s, _ = x.shape
    h = rms_norm(x, n1)
    z = jnp.einsum('bsd,dn->bsn', h, w_in)
    y_f = jnp.einsum('bsc,cd->bsd', fourier_mix(z[..., OFF_F:OFF_CA]), w_f)
    u_c = conv_module(z[..., OFF_CA:OFF_CG], z[..., OFF_CG:OFF_Q], dw, db, ln_g, ln_b)
    y_c = jnp.einsum('bsc,cd->bsd', u_c, w_c)
    q = rms_norm(z[..., OFF_Q:OFF_K].reshape(b, s, N_HEADS, HEAD_DIM), qg_)
    k = rms_norm(z[..., OFF_K:OFF_V].reshape(b, s, N_HEADS, HEAD_DIM), kg_)
    v = z[..., OFF_V:OFF_G].reshape(b, s, N_HEADS, HEAD_DIM)
    y_a = jnp.einsum('bsc,cd->bsd', neighbourhood_attention(q, k, v, rpb), w_a)
    gates = jax.nn.sigmoid(z[..., OFF_G:] + b_g).reshape(b, s, N_BRANCH, D_MODEL)
    merged = gates[:, :, 0] * y_f + gates[:, :, 1] * y_c + gates[:, :, 2] * y_a
    x = x + jnp.einsum('bsd,de->bse', merged, w_o)
    h2 = rms_norm(x, n2)
    a = jax.nn.relu(jnp.einsum('bsd,df->bsf', h2, w1))
    return x + jnp.einsum('bsf,fd->bsd', a * a, w2)


def setup_inputs(seed: int = 0) -> dict:
    key = jax.random.key(seed)
    ks = jax.random.split(key, 20)
    f32 = jnp.float32
    nrm = lambda k, shape, sc: jax.random.normal(k, shape, f32) * sc
    return {
        'x_prompt': nrm(ks[0], (BATCH, SEQ, D_MODEL), 1.0),
        'x_sample': nrm(ks[1], (DEC_BATCH, DEC_SEQ, D_MODEL), 1.0),
        'norm1_g': 1.0 + nrm(ks[2], (DEPTH, D_MODEL), 0.02),
        'w_in': nrm(ks[3], (DEPTH, D_MODEL, IN_COLS), D_MODEL ** -0.5),
        'b_gate': nrm(ks[4], (DEPTH, N_BRANCH * D_MODEL), 0.1),
        'w_fourier': nrm(ks[5], (DEPTH, F_W, D_MODEL), F_W ** -0.5),
        'conv_dw': nrm(ks[6], (DEPTH, CONV_K, C_W), CONV_K ** -0.5),
        'conv_db': nrm(ks[7], (DEPTH, C_W), 0.02),
        'conv_ln_g': 1.0 + nrm(ks[8], (DEPTH, C_W), 0.02),
        'conv_ln_b': nrm(ks[9], (DEPTH, C_W), 0.02),
        'w_conv_out': nrm(ks[10], (DEPTH, C_W, D_MODEL), C_W ** -0.5),
        'q_norm_g': 1.0 + nrm(ks[11], (DEPTH, HEAD_DIM), 0.02),
        'k_norm_g': 1.0 + nrm(ks[12], (DEPTH, HEAD_DIM), 0.02),
        'rpb': nrm(ks[13], (DEPTH, N_HEADS, 2 * WIN_R - 1, 2 * WIN_C - 1), 0.1),
        'w_attn_out': nrm(ks[14], (DEPTH, A_W, D_MODEL), A_W ** -0.5),
        'w_out': nrm(ks[15], (DEPTH, D_MODEL, D_MODEL), D_MODEL ** -0.5),
        'norm2_g': 1.0 + nrm(ks[16], (DEPTH, D_MODEL), 0.02),
        'w_mlp_in': nrm(ks[17], (DEPTH, D_MODEL, D_FF), D_MODEL ** -0.5),
        'w_mlp_out': nrm(ks[18], (DEPTH, D_FF, D_MODEL), D_FF ** -0.5),
    }


def reference(x_prompt, x_sample, norm1_g, w_in, b_gate, w_fourier, conv_dw, conv_db, conv_ln_g, conv_ln_b,
              w_conv_out, q_norm_g, k_norm_g, rpb, w_attn_out, w_out, norm2_g, w_mlp_in, w_mlp_out):
    def trunk(x):
        for l in range(DEPTH):
            x = encoder_layer(x, norm1_g[l], w_in[l], b_gate[l], w_fourier[l], conv_dw[l], conv_db[l],
                              conv_ln_g[l], conv_ln_b[l], w_conv_out[l], q_norm_g[l], k_norm_g[l], rpb[l],
                              w_attn_out[l], w_out[l], norm2_g[l], w_mlp_in[l], w_mlp_out[l])
        return x
    y_prompt = trunk(x_prompt)
    y_sample = trunk(x_sample)
    return (y_prompt, y_sample)
```

```cpp
#include <hip/hip_runtime.h>
#include <hip/hip_cooperative_groups.h>
#include <cstdio>
namespace cg = cooperative_groups;

#ifndef MODE_MULTI
#define MODE_MULTI 1
#endif

#define LAS __attribute__((address_space(3)))
typedef unsigned short bf16_t;
typedef short bf16x8 __attribute__((ext_vector_type(8)));
typedef float f32x4 __attribute__((ext_vector_type(4)));
typedef unsigned u32x4 __attribute__((ext_vector_type(4)));
typedef unsigned u32x2 __attribute__((ext_vector_type(2)));

constexpr int DM = 2048, CH = 16384, NCHUNK = 3, DFF = 8192;
constexpr int ZW = 9216;
constexpr int ZQ = 1024, ZK = 2048, ZG = 3072;
constexpr int XW = 2560;
constexpr float EPS = 1e-6f;
constexpr int NTHREADS = 512, NBLOCKS = 256, NWAVES_TOTAL = 2048;
constexpr int LDS_BYTES = 131072;

constexpr size_t SZ_WIN = (size_t)10752 * 2048 * 2, SZ_W1 = (size_t)8192 * 2048 * 2, SZ_W2 = SZ_W1, SZ_WO = (size_t)2048 * 2048 * 2, SZ_WCAT = (size_t)2048 * XW * 2;
constexpr size_t SZ_LAYER = SZ_WIN + SZ_W1 + SZ_W2 + SZ_WO + SZ_WCAT;
constexpr size_t OFF_W = 0;
constexpr size_t OFF_FM = OFF_W + 2 * SZ_LAYER;
constexpr size_t OFF_H = OFF_FM + (size_t)4096 * 2048 * 2;
constexpr size_t OFF_Z = OFF_H + (size_t)CH * 2048 * 2;
constexpr size_t OFF_TT = OFF_Z + (size_t)CH * ZW * 2;
constexpr size_t OFF_E = OFF_TT + (size_t)1536 * CH * 2;
constexpr size_t OFF_X = OFF_E + (size_t)CH * 1024 * 2;
constexpr size_t OFF_M = OFF_X + (size_t)CH * XW * 2;
constexpr size_t WS_END = OFF_M + (size_t)CH * 2048 * 2;

struct Params { const float* in[19]; float* out; unsigned char* ws; int ph_lo, ph_hi; };

__device__ __forceinline__ int opaque_tid() { int t = threadIdx.x; asm volatile("" : "+v"(t)); return t; }
__device__ __forceinline__ unsigned cvt_pk_bf16(float lo, float hi) { unsigned r; asm("v_cvt_pk_bf16_f32 %0, %1, %2" : "=v"(r) : "v"(lo), "v"(hi)); return r; }
__device__ __forceinline__ float bf_lo(unsigned w) { return __uint_as_float(w << 16); }
__device__ __forceinline__ float bf_hi(unsigned w) { return __uint_as_float(w & 0xffff0000u); }
__device__ __forceinline__ float bf2f(bf16_t b) { return __uint_as_float(((unsigned)b) << 16); }
__device__ __forceinline__ float sigmoidf_(float x) { return __builtin_amdgcn_rcpf(1.0f + __expf(-x)); }
__device__ __forceinline__ u32x4 pack8(const f32x4 a, const f32x4 b) { u32x4 w; w.x = cvt_pk_bf16(a[0], a[1]); w.y = cvt_pk_bf16(a[2], a[3]); w.z = cvt_pk_bf16(b[0], b[1]); w.w = cvt_pk_bf16(b[2], b[3]); return w; }
__device__ __forceinline__ void unpack8(const u32x4 w, f32x4& a, f32x4& b) { a[0] = bf_lo(w.x); a[1] = bf_hi(w.x); a[2] = bf_lo(w.y); a[3] = bf_hi(w.y); b[0] = bf_lo(w.z); b[1] = bf_hi(w.z); b[2] = bf_lo(w.w); b[3] = bf_hi(w.w); }

namespace pg8 {
constexpr int BM = 256, BK = 64, HALF = 128, HTB = HALF * BK * 2, STAGE_BYTES = 8 * HTB, NXCD = 8, WGM = 8;
__device__ __forceinline__ int lds_byte(int r, int c) { const int st = (r >> 4) * 2 + (c >> 5), rr = r & 15, cc = c & 31, ob = rr * 64 + cc * 2; return st * 1024 + (ob ^ (((ob >> 9) & 1) << 5)); }
__device__ __forceinline__ void stage_rc(int b, int& R, int& C) { const int st = b / 1024, sb = b % 1024, swz = sb ^ (((sb >> 9) & 1) << 5); R = (st >> 1) * 16 + swz / 64; C = (st & 1) * 32 + (swz % 64) / 2; }
__device__ __forceinline__ int perm32(int rho) { const int n = rho >> 4, i = rho & 15; return 8 * (i >> 2) + 4 * n + (i & 3); }

struct Unit { int pm, pn, aux, nt; const char* A; const char* B; };

__device__ __forceinline__ void remap(int L, int nM, int nN, int& pm, int& pn) {
    const int nwg = nM * nN; int wgid = L;
    { const int q = nwg / NXCD, r = nwg % NXCD, xcd = wgid % NXCD, off = wgid / NXCD; wgid = (xcd < r ? xcd * (q + 1) : r * (q + 1) + (xcd - r) * q) + off; }
    const int nig = WGM * nN, gid = wgid / nig, fm = gid * WGM, gsz = (nM - fm) < WGM ? (nM - fm) : WGM;
    pm = fm + ((wgid % nig) % gsz); pn = (wgid % nig) / gsz;
}

template <class Epi, class Sched>
__device__ __forceinline__ void gemm_phase(LAS unsigned char* lds, const int lda, const int ldb, const Sched& S, const Epi& E) {
    const int tid = opaque_tid(), wid = __builtin_amdgcn_readfirstlane(tid >> 6), lane = tid & 63, wr = wid >> 2, wc = wid & 3, fr = lane & 15, fq = lane >> 4;
    unsigned voffA[2], voffB[2];
#pragma unroll
    for (int i = 0; i < 2; ++i) { int R, C; stage_rc(tid * 16 + i * 8192, R, C); const int Rb = Epi::PERM ? ((R & ~31) + perm32(R & 31)) : R;
        voffA[i] = (unsigned)(R * lda + C) * 2u; voffB[i] = (unsigned)(Rb * ldb + C) * 2u; }
    const size_t kstep = (size_t)(BK * 2);
    const size_t hstepA = (size_t)HALF * lda * 2, hstepB = (size_t)HALF * ldb * 2;
    const unsigned ldsw = (unsigned)wid * 1024u;
    const int aoff = lds_byte(wr * 64 + fr, fq * 8), boff = lds_byte(wc * 32 + fr, fq * 8);
#define PG8_SA(b, h) (((b) * 2 + (h)) * HTB)
#define PG8_SB(b, h) ((4 + (b) * 2 + (h)) * HTB)
#define PG8_STAGE(bufoff, gbase, voff) do { _Pragma("unroll") for (int _i = 0; _i < 2; ++_i) \
        __builtin_amdgcn_global_load_lds((const unsigned*)((const char*)(gbase) + (voff)[_i]), (LAS unsigned*)(lds + (bufoff) + ldsw + _i * 8192), 16, 0, 0); } while (0)
#define PG8_LDA(dst, b, h) do { _Pragma("unroll") for (int m = 0; m < 4; ++m) _Pragma("unroll") for (int k = 0; k < 2; ++k) dst[m][k] = *(const LAS bf16x8*)(lds + PG8_SA(b, h) + aoff + m * 2048 + k * 1024); } while (0)
#define PG8_LDB(dst, b, h) do { _Pragma("unroll") for (int n = 0; n < 2; ++n) _Pragma("unroll") for (int k = 0; k < 2; ++k) dst[n][k] = *(const LAS bf16x8*)(lds + PG8_SB(b, h) + boff + n * 2048 + k * 1024); } while (0)
#define PG8_MMA(ai, bj, At, Bt) do { __builtin_amdgcn_s_setprio(1); _Pragma("unroll") for (int m = 0; m < 4; ++m) _Pragma("unroll") for (int n = 0; n < 2; ++n) _Pragma("unroll") for (int k = 0; k < 2; ++k) \
        acc[ai][bj][m][n] = __builtin_amdgcn_mfma_f32_16x16x32_bf16(Bt[n][k], At[m][k], acc[ai][bj][m][n], 0, 0, 0); __builtin_amdgcn_s_setprio(0); } while (0)
#define PG8_WAIT_V(n) asm volatile("s_waitcnt vmcnt(" #n ")" ::: "memory")
#define PG8_WAIT_L(n) asm volatile("s_waitcnt lgkmcnt(" #n ")" ::: "memory")
#define PG8_BAR __builtin_amdgcn_s_barrier()
#define PG8_SCHED __builtin_amdgcn_sched_barrier(0)
    Unit cur, nxt; int ui = 0;
    if (!S.next(0, cur)) return;
    f32x4 acc[2][2][4][2];
#pragma unroll
    for (int a = 0; a < 2; ++a)
#pragma unroll
        for (int b = 0; b < 2; ++b)
#pragma unroll
            for (int m = 0; m < 4; ++m)
#pragma unroll
                for (int n = 0; n < 2; ++n) acc[a][b][m][n] = (f32x4){0.f, 0.f, 0.f, 0.f};
    bf16x8 At[4][2], B0[2][2], B1[2][2];
    const char* cA = cur.A; const char* cB = cur.B;
    PG8_STAGE(PG8_SB(0, 0), cB, voffB); PG8_STAGE(PG8_SA(0, 0), cA, voffA); PG8_STAGE(PG8_SB(0, 1), cB + hstepB, voffB); PG8_STAGE(PG8_SA(0, 1), cA + hstepA, voffA);
    if (wr == 1) PG8_BAR;
    PG8_WAIT_V(4); PG8_BAR;
    PG8_STAGE(PG8_SB(1, 0), cB + kstep, voffB); PG8_STAGE(PG8_SA(1, 0), cA + kstep, voffA); PG8_STAGE(PG8_SB(1, 1), cB + hstepB + kstep, voffB);
    PG8_WAIT_V(6); PG8_BAR;
    for (;;) {
        const bool has_next = S.next(ui + 1, nxt);
        const char* nA = has_next ? nxt.A : cA; const char* nB = has_next ? nxt.B : cB;
        const int nt = cur.nt;
        for (int t = 0; t < nt; t += 2) {
            const bool last = (t == nt - 2);
            const char* a1 = cA + (size_t)(t + 1) * kstep;
            const char* a2 = last ? nA : cA + (size_t)(t + 2) * kstep; const char* b2 = last ? nB : cB + (size_t)(t + 2) * kstep;
            const char* a3 = a2 + kstep; const char* b3 = b2 + kstep;
            PG8_LDB(B0, 0, 0); PG8_SCHED; PG8_LDA(At, 0, 0); PG8_STAGE(PG8_SA(1, 1), a1 + hstepA, voffA);
            PG8_WAIT_L(8); PG8_BAR; PG8_WAIT_L(0); PG8_MMA(0, 0, At, B0); PG8_BAR; PG8_SCHED;
            PG8_LDB(B1, 0, 1); PG8_STAGE(PG8_SB(0, 0), b2, voffB);
            PG8_BAR; PG8_WAIT_L(0); PG8_MMA(0, 1, At, B1); PG8_BAR;
            PG8_LDA(At, 0, 1); PG8_STAGE(PG8_SA(0, 0), a2, voffA);
            PG8_BAR; PG8_WAIT_L(0); PG8_MMA(1, 0, At, B0); PG8_BAR; PG8_SCHED;
            PG8_STAGE(PG8_SB(0, 1), b2 + hstepB, voffB);
            PG8_WAIT_V(6); PG8_BAR; PG8_MMA(1, 1, At, B1); PG8_BAR;
            PG8_LDB(B0, 1, 0); PG8_SCHED; PG8_LDA(At, 1, 0); PG8_STAGE(PG8_SA(0, 1), a2 + hstepA, voffA);
            PG8_WAIT_L(8); PG8_BAR; PG8_WAIT_L(0); PG8_MMA(0, 0, At, B0); PG8_BAR; PG8_SCHED;
            PG8_LDB(B1, 1, 1); PG8_STAGE(PG8_SB(1, 0), b3, voffB);
            PG8_BAR; PG8_WAIT_L(0); PG8_MMA(0, 1, At, B1); PG8_BAR;
            PG8_LDA(At, 1, 1); PG8_STAGE(PG8_SA(1, 0), a3, voffA);
            PG8_BAR; PG8_WAIT_L(0); PG8_MMA(1, 0, At, B0); PG8_BAR; PG8_SCHED;
            PG8_STAGE(PG8_SB(1, 1), b3 + hstepB, voffB);
            PG8_WAIT_V(6); PG8_BAR; PG8_MMA(1, 1, At, B1); PG8_BAR;
        }
        E(acc, cur, wr, wc, fr, fq);
        if (!has_next) break;
#pragma unroll
        for (int a = 0; a < 2; ++a)
#pragma unroll
            for (int b = 0; b < 2; ++b)
#pragma unroll
                for (int m = 0; m < 4; ++m)
#pragma unroll
                    for (int n = 0; n < 2; ++n) acc[a][b][m][n] = (f32x4){0.f, 0.f, 0.f, 0.f};
        cur = nxt; cA = nA; cB = nB; ++ui;
    }
    PG8_WAIT_V(0);
    if (wr == 0) PG8_BAR;
    PG8_BAR;
#undef PG8_SA
#undef PG8_SB
#undef PG8_STAGE
#undef PG8_LDA
#undef PG8_LDB
#undef PG8_MMA
#undef PG8_WAIT_V
#undef PG8_WAIT_L
#undef PG8_BAR
#undef PG8_SCHED
}
}
using pg8::Unit;
typedef f32x4 AccT[2][2][4][2];

struct SchedB {
    const char* H; const char* W; int G, c;
    __device__ __forceinline__ bool next(int i, Unit& u) const {
        const int L = i * G + c; if (L >= 2688) return false; u.nt = 32;
        if (L < 2304) { pg8::remap(L, 64, 36, u.pm, u.pn); u.aux = 0; u.A = H + (size_t)u.pm * 256 * 2048 * 2; u.B = W + (size_t)(1536 + u.pn * 256) * 2048 * 2; }
        else { pg8::remap(L - 2304, 6, 64, u.pm, u.pn); u.aux = 1; u.A = W + (size_t)u.pm * 256 * 2048 * 2; u.B = H + (size_t)u.pn * 256 * 2048 * 2; }
        return true; }
};
struct SchedDFT {
    const char* Fm; const char* TT; int G, c;
    __device__ __forceinline__ bool next(int i, Unit& u) const {
        const int L = i * G + c; if (L >= 256) return false; int pmv, pn; pg8::remap(L, 128, 2, pmv, pn);
        const int pb = pmv >> 4; u.pm = pmv & 15; u.pn = pn; u.aux = pb; u.nt = 32;
        u.A = Fm + (size_t)u.pm * 256 * 2048 * 2; u.B = TT + ((size_t)pn * 256 * CH + (size_t)pb * 2048) * 2; return true; }
};
struct SchedMrg {
    const char* X; const char* W; int G, c;
    __device__ __forceinline__ bool next(int i, Unit& u) const {
        const int ti = i / 3, seg = i - ti * 3; const int L = ti * G + c; if (L >= 512) return false; pg8::remap(L, 64, 8, u.pm, u.pn);
        const int koff = seg == 0 ? 0 : (seg == 1 ? 1024 : 1536); u.nt = seg == 1 ? 8 : 16; u.aux = seg;
        u.A = X + ((size_t)u.pm * 256 * XW + koff) * 2; u.B = W + ((size_t)u.pn * 256 * XW + koff) * 2; return true; }
};
struct SchedPlain { const char* A; const char* B; int nM, nN, lda, ldb, nt, G, c;
    __device__ __forceinline__ bool next(int i, Unit& u) const {
        const int L = i * G + c; if (L >= nM * nN) return false; pg8::remap(L, nM, nN, u.pm, u.pn); u.aux = 0; u.nt = nt;
        u.A = A + (size_t)u.pm * 256 * lda * 2; u.B = B + (size_t)u.pn * 256 * ldb * 2; return true; }
};

struct EpiB { static constexpr bool PERM = true; bf16_t* Z; bf16_t* TT; const float* bg; int sample;
    __device__ __forceinline__ void operator()(const AccT& acc, const Unit& u, int wr, int wc, int fr, int fq) const {
        const int row0 = u.pm * 256 + wr * 64 + fr, col0 = u.pn * 256 + wc * 32 + 8 * fq;
        if (u.aux == 0) {
            const bool gate = u.pn >= 12;
#pragma unroll
            for (int bj = 0; bj < 2; ++bj) {
                f32x4 b0 = {0.f, 0.f, 0.f, 0.f}, b1 = b0;
                if (gate) { b0 = *(const f32x4*)(bg + col0 + bj * 128 - ZG); b1 = *(const f32x4*)(bg + col0 + bj * 128 - ZG + 4); }
#pragma unroll
                for (int ai = 0; ai < 2; ++ai)
#pragma unroll
                    for (int m = 0; m < 4; ++m) {
                        f32x4 v0 = acc[ai][bj][m][0], v1 = acc[ai][bj][m][1];
                        if (gate) {
#pragma unroll
                            for (int j = 0; j < 4; ++j) { v0[j] = sigmoidf_(v0[j] + b0[j]); v1[j] = sigmoidf_(v1[j] + b1[j]); } }
                        *(u32x4*)(Z + (size_t)(row0 + ai * 128 + m * 16) * ZW + col0 + bj * 128) = pack8(v0, v1);
                    }
            }
        } else {
            const bool scat = sample && u.pm < 2;
#pragma unroll
            for (int ai = 0; ai < 2; ++ai)
#pragma unroll
                for (int m = 0; m < 4; ++m) {
                    bf16_t* rp = TT + (size_t)(row0 + ai * 128 + m * 16) * CH;
#pragma unroll
                    for (int bj = 0; bj < 2; ++bj) {
                        const u32x4 w = pack8(acc[ai][bj][m][0], acc[ai][bj][m][1]);
                        const int tok = col0 + bj * 128;
                        if (!scat) *(u32x4*)(rp + tok) = w;
                        else {
                            const int b = tok >> 13, t = (tok & 8191) >> 2; bf16_t* q = rp + (b << 13) + t;
                            q[0] = (bf16_t)(w.x & 0xffff); q[2048] = (bf16_t)(w.x >> 16); q[4096] = (bf16_t)(w.y & 0xffff); q[6144] = (bf16_t)(w.y >> 16);
                            q[1] = (bf16_t)(w.z & 0xffff); q[2049] = (bf16_t)(w.z >> 16); q[4097] = (bf16_t)(w.w & 0xffff); q[6145] = (bf16_t)(w.w >> 16);
                        }
                    }
                }
        }
    }
};
struct EpiDFT { static constexpr bool PERM = true; bf16_t* X; bf16_t* E; int sample;
    __device__ __forceinline__ void operator()(const AccT& acc, const Unit& u, int wr, int wc, int fr, int fq) const {
        const int part = u.pm >> 3, s0 = (u.pm & 7) * 256 + wr * 64 + fr, pb = u.aux;
#pragma unroll
        for (int bj = 0; bj < 2; ++bj) {
            const int dcol = (u.pn * 2 + bj) * 256 + part * 128 + wc * 32 + 8 * fq;
#pragma unroll
            for (int ai = 0; ai < 2; ++ai)
#pragma unroll
                for (int m = 0; m < 4; ++m) {
                    const size_t tok = (size_t)pb * 2048 + s0 + ai * 128 + m * 16;
                    bf16_t* dst = sample ? (E + tok * 1024 + dcol) : (X + tok * XW + dcol);
                    *(u32x4*)dst = pack8(acc[ai][bj][m][0], acc[ai][bj][m][1]);
                }
        }
    }
};
struct EpiMrg { static constexpr bool PERM = true; const bf16_t* Z; bf16_t* M;
    __device__ __forceinline__ void operator()(const AccT& acc, const Unit& u, int wr, int wc, int fr, int fq) const {
        const int row0 = u.pm * 256 + wr * 64 + fr, col0 = u.pn * 256 + wc * 32 + 8 * fq, seg = u.aux;
#pragma unroll
        for (int ai = 0; ai < 2; ++ai)
#pragma unroll
            for (int m = 0; m < 4; ++m) {
                const size_t row = (size_t)(row0 + ai * 128 + m * 16);
#pragma unroll
                for (int bj = 0; bj < 2; ++bj) {
                    const u32x4 gw = *(const u32x4*)(Z + row * ZW + ZG + seg * 2048 + col0 + bj * 128);
                    f32x4 g0, g1; unpack8(gw, g0, g1);
                    f32x4 p0 = {0.f, 0.f, 0.f, 0.f}, p1 = p0;
                    bf16_t* mp = M + row * 2048 + col0 + bj * 128;
                    if (seg) { const u32x4 pw = *(const u32x4*)mp; unpack8(pw, p0, p1); }
                    *(u32x4*)mp = pack8(p0 + g0 * acc[ai][bj][m][0], p1 + g1 * acc[ai][bj][m][1]);
                }
                asm volatile("" ::: "memory");
            }
    }
};
struct EpiRes { static constexpr bool PERM = false; const float* base; float* out;
    __device__ __forceinline__ void operator()(const AccT& acc, const Unit& u, int wr, int wc, int fr, int fq) const {
        const int row0 = u.pm * 256 + wr * 64 + fr, col0 = u.pn * 256 + wc * 32 + 4 * fq;
#pragma unroll
        for (int ai = 0; ai < 2; ++ai)
#pragma unroll
            for (int m = 0; m < 4; ++m) {
                const size_t off = (size_t)(row0 + ai * 128 + m * 16) * 2048 + col0;
#pragma unroll
                for (int bj = 0; bj < 2; ++bj)
#pragma unroll
                    for (int n = 0; n < 2; ++n) { const f32x4 bs = *(const f32x4*)(base + off + bj * 128 + n * 16); *(f32x4*)(out + off + bj * 128 + n * 16) = bs + acc[ai][bj][m][n]; }
                asm volatile("" ::: "memory");
            }
    }
};
struct EpiRelu2 { static constexpr bool PERM = true; bf16_t* Hd;
    __device__ __forceinline__ void operator()(const AccT& acc, const Unit& u, int wr, int wc, int fr, int fq) const {
        const int row0 = u.pm * 256 + wr * 64 + fr, col0 = u.pn * 256 + wc * 32 + 8 * fq;
#pragma unroll
        for (int ai = 0; ai < 2; ++ai)
#pragma unroll
            for (int m = 0; m < 4; ++m)
#pragma unroll
                for (int bj = 0; bj < 2; ++bj) {
                    f32x4 v0 = acc[ai][bj][m][0], v1 = acc[ai][bj][m][1];
#pragma unroll
                    for (int j = 0; j < 4; ++j) { const float a = fmaxf(v0[j], 0.f), b = fmaxf(v1[j], 0.f); v0[j] = a * a; v1[j] = b * b; }
                    *(u32x4*)(Hd + (size_t)(row0 + ai * 128 + m * 16) * DFF + col0 + bj * 128) = pack8(v0, v1);
                }
    }
};

__device__ __forceinline__ void transpose_tile(LAS float* tile, const float* src, size_t sld, bf16_t* dst, size_t dld, const int tid) {
#pragma unroll
    for (int p = 0; p < 2; ++p) { const int i = (tid >> 4) + 32 * p, j4 = (tid & 15) * 4; const f32x4 v = *(const f32x4*)(src + (size_t)i * sld + j4);
        tile[i * 65 + j4] = v[0]; tile[i * 65 + j4 + 1] = v[1]; tile[i * 65 + j4 + 2] = v[2]; tile[i * 65 + j4 + 3] = v[3]; }
    __syncthreads();
    { const int j = tid >> 3, i8 = (tid & 7) * 8; f32x4 a, b;
#pragma unroll
      for (int q = 0; q < 4; ++q) { a[q] = tile[(i8 + q) * 65 + j]; b[q] = tile[(i8 + 4 + q) * 65 + j]; }
      *(u32x4*)(dst + (size_t)j * dld + i8) = pack8(a, b); }
    __syncthreads();
}
__device__ __forceinline__ int winT_row(int n0) {
    if (n0 < 512) return n0; if (n0 < 1024) return 1536 + (n0 - 512); if (n0 < 1536) return 2048 + (n0 - 1024);
    if (n0 < 2560) return 2560 + (n0 - 1536); if (n0 < 3584) return 3584 + (n0 - 2560); if (n0 < 4608) return 512 + (n0 - 3584); return n0;
}
__device__ void ph_prep(const Params& p, LAS unsigned char* lds) {
    LAS float* tile = (LAS float*)lds;
    const int tid = opaque_tid();
    for (int t = blockIdx.x; t < 2 * 15360; t += gridDim.x) {
        const int l = t / 15360; int r = t - l * 15360;
        unsigned char* wl = p.ws + OFF_W + (size_t)l * SZ_LAYER;
        bf16_t* WinT = (bf16_t*)wl; bf16_t* W1T = (bf16_t*)(wl + SZ_WIN); bf16_t* W2T = (bf16_t*)(wl + SZ_WIN + SZ_W1); bf16_t* WoT = (bf16_t*)(wl + SZ_WIN + SZ_W1 + SZ_W2); bf16_t* WcT = (bf16_t*)(wl + SZ_WIN + SZ_W1 + SZ_W2 + SZ_WO);
        if (r < 5376) { const int kt = r / 168, nt = r - kt * 168; transpose_tile(tile, p.in[3] + (size_t)l * 2048 * 10752 + (size_t)kt * 64 * 10752 + nt * 64, 10752, WinT + (size_t)winT_row(nt * 64) * 2048 + kt * 64, 2048, tid); continue; }
        r -= 5376;
        if (r < 4096) { const int kt = r >> 7, nt = r & 127; transpose_tile(tile, p.in[17] + (size_t)l * 2048 * 8192 + (size_t)kt * 64 * 8192 + nt * 64, 8192, W1T + (size_t)nt * 64 * 2048 + kt * 64, 2048, tid); continue; }
        r -= 4096;
        if (r < 4096) { const int kt = r >> 5, nt = r & 31; transpose_tile(tile, p.in[18] + (size_t)l * 8192 * 2048 + (size_t)kt * 64 * 2048 + nt * 64, 2048, W2T + (size_t)nt * 64 * 8192 + kt * 64, 8192, tid); continue; }
        r -= 4096;
        if (r < 1024) { const int kt = r >> 5, nt = r & 31; transpose_tile(tile, p.in[15] + (size_t)l * 2048 * 2048 + (size_t)kt * 64 * 2048 + nt * 64, 2048, WoT + (size_t)nt * 64 * 2048 + kt * 64, 2048, tid); continue; }
        r -= 1024;
        if (r < 256) { const int kt = r >> 5, nt = r & 31; transpose_tile(tile, p.in[10] + (size_t)l * 512 * 2048 + (size_t)kt * 64 * 2048 + nt * 64, 2048, WcT + (size_t)nt * 64 * XW + 1024 + kt * 64, XW, tid); continue; }
        r -= 256;
        { const int kt = r >> 5, nt = r & 31; transpose_tile(tile, p.in[14] + (size_t)l * 1024 * 2048 + (size_t)kt * 64 * 2048 + nt * 64, 2048, WcT + (size_t)nt * 64 * XW + 1536 + kt * 64, XW, tid); }
    }
    LAS float* col = (LAS float*)lds;
    LAS float* ctab = col + 512;
    LAS float* stab = ctab + 128;
    __syncthreads();
    if (tid < 128) { float s, c; sincospif((float)tid / 64.0f, &s, &c); ctab[tid] = c; stab[tid] = s; }
    for (int t = blockIdx.x; t < 2 * 2048; t += gridDim.x) {
        const int l = t >> 11, e = t & 2047;
        __syncthreads();
        col[tid] = p.in[5][(size_t)l * 512 * 2048 + (size_t)tid * 2048 + e];
        __syncthreads();
        bf16_t* WcT = (bf16_t*)(p.ws + OFF_W + (size_t)l * SZ_LAYER + SZ_WIN + SZ_W1 + SZ_W2 + SZ_WO);
#pragma unroll
        for (int q = 0; q < 2; ++q) {
            const int kp = tid + 512 * q, g = kp >> 8, part = (kp >> 7) & 1, c = kp & 127;
            float s = 0.f;
            for (int m = 0; m < 128; ++m) { const int idx = (c * m) & 127; const float tw = part ? -stab[idx] : ctab[idx]; s += tw * col[g * 128 + m]; }
            WcT[(size_t)e * XW + kp] = (bf16_t)(cvt_pk_bf16(s * 0.08838834764831845f, 0.f) & 0xffff);
        }
    }
    bf16_t* Fm = (bf16_t*)(p.ws + OFF_FM);
    for (int it = blockIdx.x * NTHREADS + tid; it < 4096 * 256; it += gridDim.x * NTHREADS) {
        const int row = it >> 8, t0 = (it & 255) * 8, s = row & 2047, part = row >> 11;
        f32x4 a, b;
#pragma unroll
        for (int j = 0; j < 8; ++j) { float sn, cs; sincospif((float)((s * (t0 + j)) & 2047) / 1024.0f, &sn, &cs); const float v = (part ? sn : cs) * 0.022097086912079608f; if (j < 4) a[j] = v; else b[j - 4] = v; }
        *(u32x4*)(Fm + (size_t)row * 2048 + t0) = pack8(a, b);
    }
}

__device__ void ph_rmsnorm(const float* x, const float* g, bf16_t* H) {
    const int tid = opaque_tid(), lane = tid & 63, gw = blockIdx.x * 8 + __builtin_amdgcn_readfirstlane(tid >> 6);
    for (int row = gw; row < CH; row += NWAVES_TOTAL) {
        const float* xr = x + (size_t)row * DM; f32x4 v[8]; float ss = 0.f;
#pragma unroll
        for (int i = 0; i < 8; ++i) { v[i] = *(const f32x4*)(xr + (i * 64 + lane) * 4); ss += v[i][0] * v[i][0] + v[i][1] * v[i][1] + v[i][2] * v[i][2] + v[i][3] * v[i][3]; }
#pragma unroll
        for (int o = 32; o >= 1; o >>= 1) ss += __shfl_xor(ss, o);
        const float rstd = rsqrtf(ss * (1.0f / DM) + EPS);
#pragma unroll
        for (int i = 0; i < 8; ++i) { const f32x4 gv = *(const f32x4*)(g + (i * 64 + lane) * 4); const f32x4 y = v[i] * rstd * gv;
            u32x2 w; w.x = cvt_pk_bf16(y[0], y[1]); w.y = cvt_pk_bf16(y[2], y[3]); *(u32x2*)(H + (size_t)row * DM + (i * 64 + lane) * 4) = w; }
    }
}

__device__ void ph_conv(const bf16_t* Z, bf16_t* X, const float* dw, const float* db, const float* lng, const float* lnb, int S, LAS unsigned char* lds) {
    LAS bf16_t* ut = (LAS bf16_t*)lds;
    LAS float* yt = (LAS float*)(lds + 65536);
    const int tid = opaque_tid(), lane = tid & 63, wid = __builtin_amdgcn_readfirstlane(tid >> 6);
    float w[31];
#pragma unroll
    for (int j = 0; j < 31; ++j) w[j] = dw[j * 512 + tid];
    const float bias = db[tid];
    for (int tl = blockIdx.x; tl < CH / 32; tl += gridDim.x) {
        const int t0 = tl * 32, ss0 = (t0 / S) * S, se = ss0 + S;
        __syncthreads();
        for (int idx = tid; idx < 62 * 64; idx += NTHREADS) {
            const int rr = idx >> 6, c8 = (idx & 63) * 8, tok = t0 - 15 + rr;
            u32x4 o = {0u, 0u, 0u, 0u};
            if (tok >= ss0 && tok < se) {
                const u32x4 aw = *(const u32x4*)(Z + (size_t)tok * ZW + c8), gw = *(const u32x4*)(Z + (size_t)tok * ZW + 512 + c8);
                f32x4 a0, a1, g0, g1; unpack8(aw, a0, a1); unpack8(gw, g0, g1);
#pragma unroll
                for (int j = 0; j < 4; ++j) { a0[j] *= sigmoidf_(g0[j]); a1[j] *= sigmoidf_(g1[j]); }
                o = pack8(a0, a1);
            }
            *(LAS u32x4*)(ut + rr * 512 + c8) = o;
        }
        __syncthreads();
        for (int tt = 0; tt < 32; ++tt) {
            float a = bias;
#pragma unroll
            for (int j = 0; j < 31; ++j) a += w[j] * bf2f(ut[(tt + j) * 512 + tid]);
            yt[tt * 512 + tid] = a;
        }
        __syncthreads();
#pragma unroll
        for (int q = 0; q < 4; ++q) {
            const int tt = wid * 4 + q;
            const f32x4 y0 = *(const LAS f32x4*)(yt + tt * 512 + lane * 8), y1 = *(const LAS f32x4*)(yt + tt * 512 + lane * 8 + 4);
            float s = (y0[0] + y0[1]) + (y0[2] + y0[3]) + (y1[0] + y1[1]) + (y1[2] + y1[3]);
#pragma unroll
            for (int o = 32; o >= 1; o >>= 1) s += __shfl_xor(s, o);
            const float mu = s * (1.0f / 512.0f);
            const f32x4 d0 = y0 - mu, d1 = y1 - mu;
            float qv = (d0[0] * d0[0] + d0[1] * d0[1]) + (d0[2] * d0[2] + d0[3] * d0[3]) + (d1[0] * d1[0] + d1[1] * d1[1]) + (d1[2] * d1[2] + d1[3] * d1[3]);
#pragma unroll
            for (int o = 32; o >= 1; o >>= 1) qv += __shfl_xor(qv, o);
            const float rstd = rsqrtf(qv * (1.0f / 512.0f) + EPS);
            const f32x4 lg0 = *(const f32x4*)(lng + lane * 8), lg1 = *(const f32x4*)(lng + lane * 8 + 4), lb0 = *(const f32x4*)(lnb + lane * 8), lb1 = *(const f32x4*)(lnb + lane * 8 + 4);
            f32x4 v0 = d0 * rstd * lg0 + lb0, v1 = d1 * rstd * lg1 + lb1;
#pragma unroll
            for (int j = 0; j < 4; ++j) { v0[j] *= sigmoidf_(v0[j]); v1[j] *= sigmoidf_(v1[j]); }
            *(u32x4*)(X + (size_t)(t0 + tt) * XW + 1024 + lane * 8) = pack8(v0, v1);
        }
    }
    __syncthreads();
}

__device__ void ph_qknorm(bf16_t* Z, const float* qg, const float* kg) {
    const int tid = opaque_tid(), lane = tid & 63, gw = blockIdx.x * 8 + __builtin_amdgcn_readfirstlane(tid >> 6);
    for (int item = gw; item < 2 * CH; item += NWAVES_TOTAL) {
        const int tok = item >> 1, isk = item & 1;
        bf16_t* ptr = Z + (size_t)tok * ZW + ZQ + isk * 1024 + lane * 16;
        const u32x4 w0 = *(const u32x4*)ptr, w1 = *(const u32x4*)(ptr + 8);
        f32x4 a0, a1, a2, a3; unpack8(w0, a0, a1); unpack8(w1, a2, a3);
        float ss = 0.f;
#pragma unroll
        for (int j = 0; j < 4; ++j) ss += a0[j] * a0[j] + a1[j] * a1[j] + a2[j] * a2[j] + a3[j] * a3[j];
        ss += __shfl_xor(ss, 1); ss += __shfl_xor(ss, 2); ss += __shfl_xor(ss, 4);
        const float rstd = rsqrtf(ss * (1.0f / 128.0f) + EPS) * (isk ? 1.0f : 0.08838834764831845f);
        const float* gp = (isk ? kg : qg) + (lane & 7) * 16;
        const f32x4 g0 = *(const f32x4*)gp, g1 = *(const f32x4*)(gp + 4), g2 = *(const f32x4*)(gp + 8), g3 = *(const f32x4*)(gp + 12);
        *(u32x4*)ptr = pack8(a0 * rstd * g0, a1 * rstd * g1); *(u32x4*)(ptr + 8) = pack8(a2 * rstd * g2, a3 * rstd * g3);
    }
}

__device__ void ph_attn(const bf16_t* Z, const bf16_t* TT, bf16_t* X, const float* rpb, int S, int rows, int nb) {
    const int tid = opaque_tid(), lane = tid & 63, g = lane >> 4, n = lane & 15, gw = blockIdx.x * 8 + __builtin_amdgcn_readfirstlane(tid >> 6);
    const int total = nb * 8 * rows * 4;
    const int kk0 = (n >> 2) * 8 + (n & 3);
    for (int u = gw; u < total; u += NWAVES_TOTAL) {
        const int j = u & 3, rr = u >> 2, r = rr % rows, bh = rr / rows, h = bh & 7, b = bh >> 3;
        const int rs = min(max(r - 4, 0), rows - 8);
        const int c0 = (j == 0) ? 0 : (j == 1) ? 8 : (j == 2) ? 24 : 32;
        const int tokq = b * S + r * 64 + j * 16 + n;
        const bf16_t* qp = Z + (size_t)tokq * ZW + ZQ + h * 128 + g * 8;
        bf16x8 qf[4];
#pragma unroll
        for (int ks = 0; ks < 4; ++ks) qf[ks] = *(const bf16x8*)(qp + ks * 32);
        f32x4 sacc[16];
#pragma unroll
        for (int i = 0; i < 8; ++i) {
            const int tokk = b * S + (rs + i) * 64 + c0;
            const bf16_t* kp0 = Z + (size_t)(tokk + kk0) * ZW + ZK + h * 128 + g * 8;
            const bf16_t* kp1 = kp0 + (size_t)4 * ZW;
            f32x4 s0 = {0.f, 0.f, 0.f, 0.f}, s1 = s0;
#pragma unroll
            for (int ks = 0; ks < 4; ++ks) {
                const bf16x8 a0 = *(const bf16x8*)(kp0 + ks * 32), a1 = *(const bf16x8*)(kp1 + ks * 32);
                s0 = __builtin_amdgcn_mfma_f32_16x16x32_bf16(a0, qf[ks], s0, 0, 0, 0);
                s1 = __builtin_amdgcn_mfma_f32_16x16x32_bf16(a1, qf[ks], s1, 0, 0, 0);
            }
            sacc[2 * i] = s0; sacc[2 * i + 1] = s1;
        }
        const int c = j * 16 + n, start = min(max(c - 8, 0), 48);
        float mx = -3.0e38f;
#pragma unroll
        for (int i = 0; i < 8; ++i) {
            const float* bp = rpb + (h * 15 + (rs + i - r + 7)) * 31;
#pragma unroll
            for (int t = 0; t < 2; ++t)
#pragma unroll
                for (int jj = 0; jj < 4; ++jj) {
                    const int kc = c0 + g * 8 + t * 4 + jj; const bool valid = (kc >= start) && (kc < start + 16);
                    const int dc = min(max(kc - c + 15, 0), 30);
                    const float sv = valid ? sacc[2 * i + t][jj] + bp[dc] : -1.0e30f;
                    sacc[2 * i + t][jj] = sv; mx = fmaxf(mx, sv);
                }
        }
        mx = fmaxf(mx, __shfl_xor(mx, 16)); mx = fmaxf(mx, __shfl_xor(mx, 32));
        float l = 0.f;
#pragma unroll
        for (int i = 0; i < 16; ++i)
#pragma unroll
            for (int jj = 0; jj < 4; ++jj) { const float pv = __expf(sacc[i][jj] - mx); sacc[i][jj] = pv; l += pv; }
        l += __shfl_xor(l, 16); l += __shfl_xor(l, 32);
        const float inv = 1.0f / l;
        f32x4 oacc[8];
#pragma unroll
        for (int dt = 0; dt < 8; ++dt) oacc[dt] = (f32x4){0.f, 0.f, 0.f, 0.f};
#pragma unroll
        for (int i = 0; i < 8; ++i) {
            const int tokk = b * S + (rs + i) * 64 + c0;
            const u32x4 pw = pack8(sacc[2 * i], sacc[2 * i + 1]);
            bf16x8 pb; __builtin_memcpy(&pb, &pw, 16);
            const bf16_t* vp = TT + (size_t)(512 + h * 128 + n) * CH + tokk + g * 8;
#pragma unroll
            for (int dt = 0; dt < 8; ++dt) {
                const bf16x8 av = *(const bf16x8*)(vp + (size_t)dt * 16 * CH);
                oacc[dt] = __builtin_amdgcn_mfma_f32_16x16x32_bf16(av, pb, oacc[dt], 0, 0, 0);
            }
        }
        bf16_t* op = X + (size_t)tokq * XW + 1536 + h * 128 + g * 4;
#pragma unroll
        for (int dt = 0; dt < 8; ++dt) { u32x2 w; w.x = cvt_pk_bf16(oacc[dt][0] * inv, oacc[dt][1] * inv); w.y = cvt_pk_bf16(oacc[dt][2] * inv, oacc[dt][3] * inv); *(u32x2*)(op + dt * 16) = w; }
    }
}

__device__ void ph_combine(const bf16_t* E, bf16_t* X) {
    const int tid = opaque_tid(), lane = tid & 63, gw = blockIdx.x * 8 + __builtin_amdgcn_readfirstlane(tid >> 6);
    const int gq = lane >> 4, c8 = (lane & 15) * 8;
    for (int item = gw; item < CH; item += NWAVES_TOTAL) {
        const int b = item >> 13, k = item & 8191, m = k & 2047;
        f32x4 xc0 = {0.f, 0.f, 0.f, 0.f}, xc1 = xc0, xs0 = xc0, xs1 = xc0;
#pragma unroll
        for (int r = 0; r < 4; ++r) {
            float sn, cs; sincospif((float)((r * k) & 8191) / 4096.0f, &sn, &cs);
            const bf16_t* ep = E + (size_t)((b * 4 + r) * 2048 + m) * 1024 + gq * 256 + c8;
            const u32x4 cw = *(const u32x4*)ep, sw = *(const u32x4*)(ep + 128);
            f32x4 ec0, ec1, es0, es1; unpack8(cw, ec0, ec1); unpack8(sw, es0, es1);
            xc0 += cs * ec0 - sn * es0; xc1 += cs * ec1 - sn * es1;
            xs0 += cs * es0 + sn * ec0; xs1 += cs * es1 + sn * ec1;
        }
        bf16_t* xp = X + (size_t)item * XW + gq * 256 + c8;
        *(u32x4*)xp = pack8(xc0 * 0.5f, xc1 * 0.5f); *(u32x4*)(xp + 128) = pack8(xs0 * 0.5f, xs1 * 0.5f);
    }
}

constexpr int N_PHASES = 1 + 2 * NCHUNK * 9;

__global__ void __launch_bounds__(NTHREADS, 2) fwd_kernel(Params p) {
    extern __shared__ __attribute__((aligned(16))) unsigned char lds_raw[];
    LAS unsigned char* lds = (LAS unsigned char*)lds_raw;
    const int G = gridDim.x, cblk = blockIdx.x;
    unsigned char* ws = p.ws;
    bf16_t* Fm = (bf16_t*)(ws + OFF_FM); bf16_t* H = (bf16_t*)(ws + OFF_H); bf16_t* Z = (bf16_t*)(ws + OFF_Z); bf16_t* HID = Z;
    bf16_t* TT = (bf16_t*)(ws + OFF_TT); bf16_t* E = (bf16_t*)(ws + OFF_E); bf16_t* X = (bf16_t*)(ws + OFF_X); bf16_t* M = (bf16_t*)(ws + OFF_M);
    for (int phi = p.ph_lo; phi < p.ph_hi; ++phi) {
        int ph = phi; asm volatile("" : "+s"(ph));
        if (ph == 0) { ph_prep(p, lds); }
        else {
            const int q = ph - 1, layer = q / (NCHUNK * 9), chunk = (q / 9) % NCHUNK, sub = q % 9;
            const int sample = chunk == 2, S = sample ? 8192 : 2048, rows = S / 64, nb = CH / S;
            const unsigned char* wl = ws + OFF_W + (size_t)layer * SZ_LAYER;
            const char* WinT = (const char*)wl; const char* W1T = (const char*)(wl + SZ_WIN); const char* W2T = (const char*)(wl + SZ_WIN + SZ_W1);
            const char* WoT = (const char*)(wl + SZ_WIN + SZ_W1 + SZ_W2); const char* WcT = (const char*)(wl + SZ_WIN + SZ_W1 + SZ_W2 + SZ_WO);
            float* xout = p.out + (size_t)chunk * CH * DM;
            const float* xin = layer == 0 ? (sample ? p.in[1] : p.in[0] + (size_t)chunk * CH * DM) : xout;
            switch (sub) {
            case 0: ph_rmsnorm(xin, p.in[2] + layer * DM, H); break;
            case 1: { SchedB Sc{(const char*)H, WinT, G, cblk}; EpiB Ep{Z, TT, p.in[4] + layer * 6144, sample}; pg8::gemm_phase(lds, 2048, 2048, Sc, Ep); } break;
            case 2: { SchedDFT Sc{(const char*)Fm, (const char*)TT, G, cblk}; EpiDFT Ep{X, E, sample}; pg8::gemm_phase(lds, 2048, CH, Sc, Ep);
                      __syncthreads();
                      ph_conv(Z, X, p.in[6] + layer * 31 * 512, p.in[7] + layer * 512, p.in[8] + layer * 512, p.in[9] + layer * 512, S, lds);
                      ph_qknorm(Z, p.in[11] + layer * 128, p.in[12] + layer * 128); } break;
            case 3: ph_attn(Z, TT, X, p.in[13] + layer * 8 * 15 * 31, S, rows, nb); if (sample) ph_combine(E, X); break;
            case 4: { SchedMrg Sc{(const char*)X, WcT, G, cblk}; EpiMrg Ep{Z, M}; pg8::gemm_phase(lds, XW, XW, Sc, Ep); } break;
            case 5: { SchedPlain Sc{(const char*)M, WoT, 64, 8, 2048, 2048, 32, G, cblk}; EpiRes Ep{xin, xout}; pg8::gemm_phase(lds, 2048, 2048, Sc, Ep); } break;
            case 6: ph_rmsnorm(xout, p.in[16] + layer * DM, H); break;
            case 7: { SchedPlain Sc{(const char*)H, W1T, 64, 32, 2048, 2048, 32, G, cblk}; EpiRelu2 Ep{HID}; pg8::gemm_phase(lds, 2048, 2048, Sc, Ep); } break;
            case 8: { SchedPlain Sc{(const char*)HID, W2T, 64, 8, 8192, 8192, 128, G, cblk}; EpiRes Ep{xout, xout}; pg8::gemm_phase(lds, 8192, 8192, Sc, Ep); } break;
            }
        }
        asm volatile("" ::: "memory");
        if (phi + 1 < p.ph_hi) { cg::this_grid().sync(); }
    }
}

extern "C" void kernel_launch(void* const* d_in, const int* in_sizes, int n_in, void* d_out, int out_size, void* d_ws, size_t ws_size, hipStream_t stream) {
    static int ready = 0;
    if (!ready) {
        if (n_in != 19 || ws_size < WS_END) { fprintf(stderr, "kernel_launch: unexpected n_in %d / ws_size %zu (need %zu)\n", n_in, ws_size, (size_t)WS_END); ready = -1; return; }
        if (hipFuncSetAttribute((const void*)fwd_kernel, hipFuncAttributeMaxDynamicSharedMemorySize, LDS_BYTES) != hipSuccess) { fprintf(stderr, "kernel_launch: hipFuncSetAttribute failed\n"); ready = -1; return; }
        int per_cu = 0;
        if (hipOccupancyMaxActiveBlocksPerMultiprocessor(&per_cu, (const void*)fwd_kernel, NTHREADS, LDS_BYTES) != hipSuccess || per_cu < 1) fprintf(stderr, "kernel_launch: occupancy query says %d blocks per CU\n", per_cu);
        (void)hipGetLastError();
        ready = 1;
    }
    if (ready < 0) return;
    Params p{};
    for (int i = 0; i < 19; ++i) p.in[i] = (const float*)d_in[i];
    p.out = (float*)d_out; p.ws = (unsigned char*)d_ws;
#if MODE_MULTI
    for (int ph = 0; ph < N_PHASES; ++ph) { p.ph_lo = ph; p.ph_hi = ph + 1; hipLaunchKernelGGL(fwd_kernel, dim3(NBLOCKS), dim3(NTHREADS), LDS_BYTES, stream, p); }
#else
    p.ph_lo = 0; p.ph_hi = N_PHASES;
    void* args[] = {&p};
    hipError_t e = hipLaunchCooperativeKernel((const void*)fwd_kernel, dim3(NBLOCKS), dim3(NTHREADS), args, LDS_BYTES, stream);
    if (e != hipSuccess) fprintf(stderr, "cooperative launch failed: %s\n", hipGetErrorString(e));
#endif
}
```

```cpp
#include <hip/hip_runtime.h>
#include <hip/hip_cooperative_groups.h>
#include <cstdio>
namespace cg = cooperative_groups;

#ifndef PROBE_DUP
#define PROBE_DUP -1
#endif
#ifndef PROBE_SYNCS
#define PROBE_SYNCS 0
#endif
#ifndef MODE_MULTI
#define MODE_MULTI 0
#endif

#define LAS __attribute__((address_space(3)))
typedef unsigned short bf16_t;
typedef short bf16x8 __attribute__((ext_vector_type(8)));
typedef float f32x4 __attribute__((ext_vector_type(4)));
typedef unsigned u32x4 __attribute__((ext_vector_type(4)));
typedef unsigned u32x2 __attribute__((ext_vector_type(2)));

constexpr int DM = 2048, CH = 16384, NCHUNK = 3, DFF = 8192;
constexpr int ZW = 9216;
constexpr int ZQ = 1024, ZK = 2048, ZG = 3072;
constexpr int XW = 2560;
constexpr float EPS = 1e-6f;
constexpr int NTHREADS = 512, NBLOCKS = 256, NWAVES_TOTAL = 2048;
constexpr int LDS_BAR_OFF = 15360 + 131072;
constexpr int LDS_BYTES = LDS_BAR_OFF + 16;

constexpr size_t SZ_WIN = (size_t)10752 * 2048 * 2, SZ_W1 = (size_t)8192 * 2048 * 2, SZ_W2 = SZ_W1, SZ_WO = (size_t)2048 * 2048 * 2, SZ_WCAT = (size_t)2048 * XW * 2;
constexpr size_t SZ_LAYER = SZ_WIN + SZ_W1 + SZ_W2 + SZ_WO + SZ_WCAT;
constexpr size_t OFF_W = 0;
constexpr size_t OFF_FM = OFF_W + 2 * SZ_LAYER;
constexpr size_t OFF_H = OFF_FM + (size_t)4096 * 2048 * 2;
constexpr size_t OFF_Z = OFF_H + (size_t)CH * 2048 * 2;
constexpr size_t OFF_TT = OFF_Z + (size_t)CH * ZW * 2;
constexpr size_t OFF_E = OFF_TT + (size_t)1536 * CH * 2;
constexpr size_t OFF_X = OFF_E + (size_t)CH * 1024 * 2;
constexpr size_t OFF_M = OFF_X + (size_t)CH * XW * 2;
constexpr size_t OFF_BAR = OFF_M + (size_t)CH * 2048 * 2;
constexpr size_t BAR_BYTES = 16384;
constexpr size_t OFF_SS1 = OFF_BAR + BAR_BYTES;
constexpr size_t OFF_SS2 = OFF_SS1 + (size_t)CH * 4;
constexpr size_t WS_END = OFF_SS2 + (size_t)CH * 4;

struct Params { const float* in[19]; float* out; unsigned char* ws; int ph_lo, ph_hi; };

__device__ __forceinline__ int opaque_tid(int wid) { int wv_ = wid; asm volatile("" : "+v"(wv_)); wv_ = __builtin_amdgcn_readfirstlane(wv_); unsigned ones = ~0u; asm volatile("" : "+s"(ones)); int t = (wv_ << 6) | (int)__builtin_amdgcn_mbcnt_hi(ones, __builtin_amdgcn_mbcnt_lo(ones, 0u)); asm volatile("" : "+v"(t)); return t; }
__device__ __forceinline__ LAS unsigned char* local_lds(LAS unsigned char* l) { unsigned u = (unsigned)(size_t)l; asm volatile("" : "+s"(u)); return (LAS unsigned char*)(size_t)u; }
__device__ __forceinline__ unsigned cvt_pk_bf16(float lo, float hi) { unsigned r; asm("v_cvt_pk_bf16_f32 %0, %1, %2" : "=v"(r) : "v"(lo), "v"(hi)); return r; }
__device__ __forceinline__ float bf_lo(unsigned w) { return __uint_as_float(w << 16); }
__device__ __forceinline__ float bf_hi(unsigned w) { return __uint_as_float(w & 0xffff0000u); }
__device__ __forceinline__ float bf2f(bf16_t b) { return __uint_as_float(((unsigned)b) << 16); }
__device__ __forceinline__ float rstd_of(float ss) { return rsqrtf(ss * (1.0f / DM) + EPS); }
__device__ __forceinline__ float sigmoidf_(float x) { return __builtin_amdgcn_rcpf(1.0f + __expf(-x)); }
__device__ __forceinline__ u32x4 pack8(const f32x4 a, const f32x4 b) { u32x4 w; w.x = cvt_pk_bf16(a[0], a[1]); w.y = cvt_pk_bf16(a[2], a[3]); w.z = cvt_pk_bf16(b[0], b[1]); w.w = cvt_pk_bf16(b[2], b[3]); return w; }
__device__ __forceinline__ void unpack8(const u32x4 w, f32x4& a, f32x4& b) { a[0] = bf_lo(w.x); a[1] = bf_hi(w.x); a[2] = bf_lo(w.y); a[3] = bf_hi(w.y); b[0] = bf_lo(w.z); b[1] = bf_hi(w.z); b[2] = bf_lo(w.w); b[3] = bf_hi(w.w); }

namespace pg8 {
constexpr int BM = 256, BK = 64, HALF = 128, HTB = HALF * BK * 2, STAGE_BYTES = 8 * HTB, NXCD = 8, WGM = 8;
__device__ __forceinline__ int lds_byte(int r, int c) { const int st = (r >> 4) * 2 + (c >> 5), rr = r & 15, cc = c & 31, ob = rr * 64 + cc * 2; return st * 1024 + (ob ^ (((ob >> 9) & 1) << 5)); }
__device__ __forceinline__ void stage_rc(int b, int& R, int& C) { const int st = b / 1024, sb = b % 1024, swz = sb ^ (((sb >> 9) & 1) << 5); R = (st >> 1) * 16 + swz / 64; C = (st & 1) * 32 + (swz % 64) / 2; }
__device__ __forceinline__ int perm32(int rho) { const int n = rho >> 4, i = rho & 15; return 8 * (i >> 2) + 4 * n + (i & 3); }

struct Unit { int pm, pn, aux, nt; const char* A; const char* B; };

__device__ __forceinline__ void remap(int L, int nM, int nN, int& pm, int& pn) {
    const int nwg = nM * nN; int wgid = L;
    { const int q = nwg / NXCD, r = nwg % NXCD, xcd = wgid % NXCD, off = wgid / NXCD; wgid = (xcd < r ? xcd * (q + 1) : r * (q + 1) + (xcd - r) * q) + off; }
    const int nig = WGM * nN, gid = wgid / nig, fm = gid * WGM, gsz = (nM - fm) < WGM ? (nM - fm) : WGM;
    pm = fm + ((wgid % nig) % gsz); pn = (wgid % nig) / gsz;
}

template <class Epi, class Sched>
__device__ __forceinline__ void gemm_phase(LAS unsigned char* lds_in, const int lda, const int ldb, const Sched& S, const Epi& E, const int WID) {
    unsigned lds_u = (unsigned)(size_t)lds_in; asm volatile("" : "+s"(lds_u));
    LAS unsigned char* lds = (LAS unsigned char*)(size_t)lds_u;
    const int tid = opaque_tid(WID), wid = __builtin_amdgcn_readfirstlane(tid >> 6), lane = tid & 63, wr = wid >> 2, wc = wid & 3, fr = lane & 15, fq = lane >> 4;
    unsigned voffA[2], voffB[2];
#pragma unroll
    for (int i = 0; i < 2; ++i) { int R, C; stage_rc(tid * 16 + i * 8192, R, C); const int Rb = Epi::PERM ? ((R & ~31) + perm32(R & 31)) : R;
        voffA[i] = (unsigned)(R * lda + C) * 2u; voffB[i] = (unsigned)(Rb * ldb + C) * 2u; }
    const size_t kstep = (size_t)(BK * 2);
    const size_t hstepA = (size_t)HALF * lda * 2, hstepB = (size_t)HALF * ldb * 2;
    const unsigned ldsw = (unsigned)wid * 1024u;
    const int aoff = lds_byte(wr * 64 + fr, fq * 8), boff = lds_byte(wc * 32 + fr, fq * 8);
#define PG8_SA(b, h) (((b) * 2 + (h)) * HTB)
#define PG8_SB(b, h) ((4 + (b) * 2 + (h)) * HTB)
#define PG8_STAGE(bufoff, gbase, voff) do { _Pragma("unroll") for (int _i = 0; _i < 2; ++_i) \
        __builtin_amdgcn_global_load_lds((const unsigned*)((const char*)(gbase) + (voff)[_i]), (LAS unsigned*)(lds + (bufoff) + ldsw + _i * 8192), 16, 0, 0); } while (0)
#define PG8_LDA(dst, b, h) do { _Pragma("unroll") for (int m = 0; m < 4; ++m) _Pragma("unroll") for (int k = 0; k < 2; ++k) dst[m][k] = *(const LAS bf16x8*)(lds + PG8_SA(b, h) + aoff + m * 2048 + k * 1024); } while (0)
#define PG8_LDB(dst, b, h) do { _Pragma("unroll") for (int n = 0; n < 2; ++n) _Pragma("unroll") for (int k = 0; k < 2; ++k) dst[n][k] = *(const LAS bf16x8*)(lds + PG8_SB(b, h) + boff + n * 2048 + k * 1024); } while (0)
#define PG8_MMA(ai, bj, At, Bt) do { __builtin_amdgcn_s_setprio(1); _Pragma("unroll") for (int m = 0; m < 4; ++m) _Pragma("unroll") for (int n = 0; n < 2; ++n) _Pragma("unroll") for (int k = 0; k < 2; ++k) \
        acc[ai][bj][m][n] = __builtin_amdgcn_mfma_f32_16x16x32_bf16(Bt[n][k], At[m][k], acc[ai][bj][m][n], 0, 0, 0); __builtin_amdgcn_s_setprio(0); } while (0)
#define PG8_WAIT_V(n) asm volatile("s_waitcnt vmcnt(" #n ")" ::: "memory")
#define PG8_WAIT_L(n) asm volatile("s_waitcnt lgkmcnt(" #n ")" ::: "memory")
#define PG8_BAR __builtin_amdgcn_s_barrier()
#define PG8_SCHED __builtin_amdgcn_sched_barrier(0)
    Unit cur, nxt; int ui = 0;
    if (!S.next(0, cur)) return;
    f32x4 acc[2][2][4][2];
#pragma unroll
    for (int a = 0; a < 2; ++a)
#pragma unroll
        for (int b = 0; b < 2; ++b)
#pragma unroll
            for (int m = 0; m < 4; ++m)
#pragma unroll
                for (int n = 0; n < 2; ++n) acc[a][b][m][n] = (f32x4){0.f, 0.f, 0.f, 0.f};
    bf16x8 At[4][2], B0[2][2], B1[2][2];
    const char* cA = cur.A; const char* cB = cur.B;
    PG8_STAGE(PG8_SB(0, 0), cB, voffB); PG8_STAGE(PG8_SA(0, 0), cA, voffA); PG8_STAGE(PG8_SB(0, 1), cB + hstepB, voffB); PG8_STAGE(PG8_SA(0, 1), cA + hstepA, voffA);
    if (wr == 1) PG8_BAR;
    PG8_WAIT_V(4); PG8_BAR;
    PG8_STAGE(PG8_SB(1, 0), cB + kstep, voffB); PG8_STAGE(PG8_SA(1, 0), cA + kstep, voffA); PG8_STAGE(PG8_SB(1, 1), cB + hstepB + kstep, voffB);
    PG8_WAIT_V(6); PG8_BAR;
    for (;;) {
        const bool has_next = S.next(ui + 1, nxt);
        const char* nA = has_next ? nxt.A : cA; const char* nB = has_next ? nxt.B : cB;
        const int nt = cur.nt;
        for (int sg = 0; sg < (Epi::HAS_MID ? 3 : 1); ++sg) {
        const int tb = Epi::HAS_MID ? (sg == 0 ? 0 : (sg == 1 ? 16 : 24)) : 0, te = Epi::HAS_MID ? (sg == 0 ? 16 : (sg == 1 ? 24 : nt)) : nt;
        if constexpr (Epi::HAS_MID) { if (sg > 0) { PG8_SCHED; E.mid(acc, cur, tb, wr, wc, fr, fq); PG8_SCHED; } }
        for (int t = tb; t < te; t += 2) {
            const bool last = (t == nt - 2);
            const char* a1 = cA + (size_t)(t + 1) * kstep;
            const char* a2 = last ? nA : cA + (size_t)(t + 2) * kstep; const char* b2 = last ? nB : cB + (size_t)(t + 2) * kstep;
            const char* a3 = a2 + kstep; const char* b3 = b2 + kstep;
            PG8_LDB(B0, 0, 0); PG8_SCHED; PG8_LDA(At, 0, 0); PG8_STAGE(PG8_SA(1, 1), a1 + hstepA, voffA);
            PG8_WAIT_L(8); PG8_BAR; PG8_WAIT_L(0); PG8_MMA(0, 0, At, B0); PG8_BAR; PG8_SCHED;
            PG8_LDB(B1, 0, 1); PG8_STAGE(PG8_SB(0, 0), b2, voffB);
            PG8_BAR; PG8_WAIT_L(0); PG8_MMA(0, 1, At, B1); PG8_BAR;
            PG8_LDA(At, 0, 1); PG8_STAGE(PG8_SA(0, 0), a2, voffA);
            PG8_BAR; PG8_WAIT_L(0); PG8_MMA(1, 0, At, B0); PG8_BAR; PG8_SCHED;
            PG8_STAGE(PG8_SB(0, 1), b2 + hstepB, voffB);
            PG8_WAIT_V(6); PG8_BAR; PG8_MMA(1, 1, At, B1); PG8_BAR;
            PG8_LDB(B0, 1, 0); PG8_SCHED; PG8_LDA(At, 1, 0); PG8_STAGE(PG8_SA(0, 1), a2 + hstepA, voffA);
            PG8_WAIT_L(8); PG8_BAR; PG8_WAIT_L(0); PG8_MMA(0, 0, At, B0); PG8_BAR; PG8_SCHED;
            PG8_LDB(B1, 1, 1); PG8_STAGE(PG8_SB(1, 0), b3, voffB);
            PG8_BAR; PG8_WAIT_L(0); PG8_MMA(0, 1, At, B1); PG8_BAR;
            PG8_LDA(At, 1, 1); PG8_STAGE(PG8_SA(1, 0), a3, voffA);
            PG8_BAR; PG8_WAIT_L(0); PG8_MMA(1, 0, At, B0); PG8_BAR; PG8_SCHED;
            PG8_STAGE(PG8_SB(1, 1), b3 + hstepB, voffB);
            PG8_WAIT_V(6); PG8_BAR; PG8_MMA(1, 1, At, B1); PG8_BAR;
        }
        }
        E(acc, cur, wr, wc, fr, fq);
        if (!has_next) break;
#pragma unroll
        for (int a = 0; a < 2; ++a)
#pragma unroll
            for (int b = 0; b < 2; ++b)
#pragma unroll
                for (int m = 0; m < 4; ++m)
#pragma unroll
                    for (int n = 0; n < 2; ++n) acc[a][b][m][n] = (f32x4){0.f, 0.f, 0.f, 0.f};
        cur = nxt; cA = nA; cB = nB; ++ui;
    }
    PG8_WAIT_V(0);
    if (wr == 0) PG8_BAR;
    PG8_BAR;
#undef PG8_SA
#undef PG8_SB
#undef PG8_STAGE
#undef PG8_LDA
#undef PG8_LDB
#undef PG8_MMA
#undef PG8_WAIT_V
#undef PG8_WAIT_L
#undef PG8_BAR
#undef PG8_SCHED
}
}
using pg8::Unit;
typedef f32x4 AccT[2][2][4][2];

struct SchedB {
    const char* H; const char* W; int G, c;
    __device__ __forceinline__ bool next(int i, Unit& u) const {
        const int L = i * G + c; if (L >= 2688) return false; u.nt = 32;
        if (L < 2304) { pg8::remap(L, 64, 36, u.pm, u.pn); u.aux = 0; u.A = H + (size_t)u.pm * 256 * 2048 * 2; u.B = W + (size_t)(1536 + u.pn * 256) * 2048 * 2; }
        else { pg8::remap(L - 2304, 6, 64, u.pm, u.pn); u.aux = 1; u.A = W + (size_t)u.pm * 256 * 2048 * 2; u.B = H + (size_t)u.pn * 256 * 2048 * 2; }
        return true; }
};
struct SchedDFT {
    const char* Fm; const char* TT; int G, c;
    __device__ __forceinline__ bool next(int i, Unit& u) const {
        const int L = i * G + c; if (L >= 256) return false; int pmv, pn; pg8::remap(L, 128, 2, pmv, pn);
        const int pb = pmv >> 4; u.pm = pmv & 15; u.pn = pn; u.aux = pb; u.nt = 32;
        u.A = Fm + (size_t)u.pm * 256 * 2048 * 2; u.B = TT + ((size_t)pn * 256 * CH + (size_t)pb * 2048) * 2; return true; }
};
struct SchedMrg {
    const char* X; const char* W; int G, c;
    __device__ __forceinline__ bool next(int i, Unit& u) const {
        const int ti = i / 3, seg = i - ti * 3; const int L = ti * G + c; if (L >= 512) return false; pg8::remap(L, 64, 8, u.pm, u.pn);
        const int koff = seg == 0 ? 0 : (seg == 1 ? 1024 : 1536); u.nt = seg == 1 ? 8 : 16; u.aux = seg;
        u.A = X + ((size_t)u.pm * 256 * XW + koff) * 2; u.B = W + ((size_t)u.pn * 256 * XW + koff) * 2; return true; }
};
struct SchedPlain { const char* A; const char* B; int nM, nN, lda, ldb, nt, G, c;
    __device__ __forceinline__ bool next(int i, Unit& u) const {
        const int L = i * G + c; if (L >= nM * nN) return false; pg8::remap(L, nM, nN, u.pm, u.pn); u.aux = 0; u.nt = nt;
        u.A = A + (size_t)u.pm * 256 * lda * 2; u.B = B + (size_t)u.pn * 256 * ldb * 2; return true; }
};

struct EpiB { static constexpr bool PERM = true, HAS_MID = false; bf16_t* Z; bf16_t* TT; const float* bg; const float* SS; int sample;
    __device__ __forceinline__ void operator()(const AccT& acc, const Unit& u, int wr, int wc, int fr, int fq) const {
        const int row0 = u.pm * 256 + wr * 64 + fr, col0 = u.pn * 256 + wc * 32 + 8 * fq;
        if (u.aux == 0) {
            const bool gate = u.pn >= 12;
            float rsv[2][4]; f32x4 bb0[2], bb1[2];
#pragma unroll
            for (int ai = 0; ai < 2; ++ai)
#pragma unroll
                for (int m = 0; m < 4; ++m) rsv[ai][m] = SS[row0 + ai * 128 + m * 16];
#pragma unroll
            for (int bj = 0; bj < 2; ++bj) { bb0[bj] = (f32x4){0.f, 0.f, 0.f, 0.f}; bb1[bj] = bb0[bj];
                if (gate) { bb0[bj] = *(const f32x4*)(bg + col0 + bj * 128 - ZG); bb1[bj] = *(const f32x4*)(bg + col0 + bj * 128 - ZG + 4); } }
#pragma unroll
            for (int bj = 0; bj < 2; ++bj) {
                const f32x4 b0 = bb0[bj], b1 = bb1[bj];
#pragma unroll
                for (int ai = 0; ai < 2; ++ai)
#pragma unroll
                    for (int m = 0; m < 4; ++m) {
                        const float rs = rstd_of(rsv[ai][m]);
                        f32x4 v0 = acc[ai][bj][m][0] * rs, v1 = acc[ai][bj][m][1] * rs;
                        if (gate) {
#pragma unroll
                            for (int j = 0; j < 4; ++j) { v0[j] = sigmoidf_(v0[j] + b0[j]); v1[j] = sigmoidf_(v1[j] + b1[j]); } }
                        *(u32x4*)(Z + (size_t)(row0 + ai * 128 + m * 16) * ZW + col0 + bj * 128) = pack8(v0, v1);
                    }
            }
        } else {
            const bool scat = sample && u.pm < 2;
            f32x4 rs0[2], rs1[2];
#pragma unroll
            for (int bj = 0; bj < 2; ++bj) { const f32x4 a = *(const f32x4*)(SS + col0 + bj * 128), b = *(const f32x4*)(SS + col0 + bj * 128 + 4);
#pragma unroll
                for (int j = 0; j < 4; ++j) { rs0[bj][j] = rstd_of(a[j]); rs1[bj][j] = rstd_of(b[j]); } }
#pragma unroll
            for (int ai = 0; ai < 2; ++ai)
#pragma unroll
                for (int m = 0; m < 4; ++m) {
                    bf16_t* rp = TT + (size_t)(row0 + ai * 128 + m * 16) * CH;
#pragma unroll
                    for (int bj = 0; bj < 2; ++bj) {
                        const u32x4 w = pack8(acc[ai][bj][m][0] * rs0[bj], acc[ai][bj][m][1] * rs1[bj]);
                        const int tok = col0 + bj * 128;
                        if (!scat) *(u32x4*)(rp + tok) = w;
                        else {
                            const int b = tok >> 13, t = (tok & 8191) >> 2; bf16_t* q = rp + (b << 13) + t;
                            q[0] = (bf16_t)(w.x & 0xffff); q[2048] = (bf16_t)(w.x >> 16); q[4096] = (bf16_t)(w.y & 0xffff); q[6144] = (bf16_t)(w.y >> 16);
                            q[1] = (bf16_t)(w.z & 0xffff); q[2049] = (bf16_t)(w.z >> 16); q[4097] = (bf16_t)(w.w & 0xffff); q[6145] = (bf16_t)(w.w >> 16);
                        }
                    }
                }
        }
    }
};
struct EpiDFT { static constexpr bool PERM = true, HAS_MID = false; bf16_t* X; bf16_t* E; int sample;
    __device__ __forceinline__ void operator()(const AccT& acc, const Unit& u, int wr, int wc, int fr, int fq) const {
        const int part = u.pm >> 3, s0 = (u.pm & 7) * 256 + wr * 64 + fr, pb = u.aux;
#pragma unroll
        for (int bj = 0; bj < 2; ++bj) {
            const int dcol = (u.pn * 2 + bj) * 256 + part * 128 + wc * 32 + 8 * fq;
#pragma unroll
            for (int ai = 0; ai < 2; ++ai)
#pragma unroll
                for (int m = 0; m < 4; ++m) {
                    const size_t tok = (size_t)pb * 2048 + s0 + ai * 128 + m * 16;
                    bf16_t* dst = sample ? (E + tok * 1024 + dcol) : (X + tok * XW + dcol);
                    *(u32x4*)dst = pack8(acc[ai][bj][m][0], acc[ai][bj][m][1]);
                }
        }
    }
};
struct EpiMrg { static constexpr bool PERM = true, HAS_MID = false; const bf16_t* Z; bf16_t* M;
    __device__ __forceinline__ void operator()(const AccT& acc, const Unit& u, int wr, int wc, int fr, int fq) const {
        const int row0 = u.pm * 256 + wr * 64 + fr, col0 = u.pn * 256 + wc * 32 + 8 * fq, seg = u.aux;
#pragma unroll
        for (int ai = 0; ai < 2; ++ai)
#pragma unroll
            for (int m = 0; m < 4; ++m) {
                const size_t row = (size_t)(row0 + ai * 128 + m * 16);
#pragma unroll
                for (int bj = 0; bj < 2; ++bj) {
                    const u32x4 gw = *(const u32x4*)(Z + row * ZW + ZG + seg * 2048 + col0 + bj * 128);
                    f32x4 g0, g1; unpack8(gw, g0, g1);
                    f32x4 p0 = {0.f, 0.f, 0.f, 0.f}, p1 = p0;
                    bf16_t* mp = M + row * 2048 + col0 + bj * 128;
                    if (seg) { const u32x4 pw = *(const u32x4*)mp; unpack8(pw, p0, p1); }
                    *(u32x4*)mp = pack8(p0 + g0 * acc[ai][bj][m][0], p1 + g1 * acc[ai][bj][m][1]);
                }
                asm volatile("" ::: "memory");
            }
    }
};
struct EpiMrg2 { static constexpr bool PERM = true, HAS_MID = true; const bf16_t* Z; bf16_t* M;
    __device__ __forceinline__ void mid(AccT& acc, const Unit& u, int t, int wr, int wc, int fr, int fq) const {
        int row0 = u.pm * 256 + wr * 64 + fr, col0 = u.pn * 256 + wc * 32 + 8 * fq; const int seg = (t == 16) ? 0 : 1;
        asm volatile("" : "+v"(row0), "+v"(col0));
#pragma unroll
        for (int ai = 0; ai < 2; ++ai) {
            u32x4 ga[4][2], gb[4][2];
#pragma unroll
            for (int m = 0; m < 4; ++m)
#pragma unroll
                for (int bj = 0; bj < 2; ++bj) { const bf16_t* gp = Z + (size_t)(row0 + ai * 128 + m * 16) * ZW + ZG + seg * 2048 + col0 + bj * 128; ga[m][bj] = *(const u32x4*)gp; gb[m][bj] = *(const u32x4*)(gp + 2048); }
#pragma unroll
            for (int m = 0; m < 4; ++m)
#pragma unroll
                for (int bj = 0; bj < 2; ++bj) {
                    f32x4 a0, a1, b0, b1; unpack8(ga[m][bj], a0, a1); unpack8(gb[m][bj], b0, b1);
#pragma unroll
                    for (int j = 0; j < 4; ++j) { a0[j] = fmaxf(a0[j], 1e-20f) * __builtin_amdgcn_rcpf(fmaxf(b0[j], 1e-20f)); a1[j] = fmaxf(a1[j], 1e-20f) * __builtin_amdgcn_rcpf(fmaxf(b1[j], 1e-20f)); }
                    acc[ai][bj][m][0] *= a0; acc[ai][bj][m][1] *= a1;
                }
            asm volatile("" ::: "memory");
        }
    }
    __device__ __forceinline__ void operator()(const AccT& acc, const Unit& u, int wr, int wc, int fr, int fq) const {
        int row0 = u.pm * 256 + wr * 64 + fr, col0 = u.pn * 256 + wc * 32 + 8 * fq;
        asm volatile("" : "+v"(row0), "+v"(col0));
        u32x4 gw[2][4][2];
#pragma unroll
        for (int ai = 0; ai < 2; ++ai)
#pragma unroll
            for (int m = 0; m < 4; ++m)
#pragma unroll
                for (int bj = 0; bj < 2; ++bj) gw[ai][m][bj] = *(const u32x4*)(Z + (size_t)(row0 + ai * 128 + m * 16) * ZW + ZG + 2 * 2048 + col0 + bj * 128);
#pragma unroll
        for (int ai = 0; ai < 2; ++ai)
#pragma unroll
            for (int m = 0; m < 4; ++m) {
                const size_t row = (size_t)(row0 + ai * 128 + m * 16);
#pragma unroll
                for (int bj = 0; bj < 2; ++bj) {
                    f32x4 g0, g1; unpack8(gw[ai][m][bj], g0, g1);
#pragma unroll
                    for (int j = 0; j < 4; ++j) { g0[j] = fmaxf(g0[j], 1e-20f); g1[j] = fmaxf(g1[j], 1e-20f); }
                    *(u32x4*)(M + row * 2048 + col0 + bj * 128) = pack8(g0 * acc[ai][bj][m][0], g1 * acc[ai][bj][m][1]);
                }
            }
    }
};
struct EpiRes { static constexpr bool PERM = true, HAS_MID = false; bf16_t* Hb; float* outF; float* SS;
    __device__ __forceinline__ void operator()(const AccT& acc, const Unit& u, int wr, int wc, int fr, int fq) const {
        int row0 = u.pm * 256 + wr * 64 + fr, col0 = u.pn * 256 + wc * 32 + 8 * fq;
        asm volatile("" : "+v"(row0), "+v"(col0));
        u32x4 bw[2][4][2];
#pragma unroll
        for (int ai = 0; ai < 2; ++ai)
#pragma unroll
            for (int m = 0; m < 4; ++m)
#pragma unroll
                for (int bj = 0; bj < 2; ++bj) bw[ai][m][bj] = *(const u32x4*)(Hb + (size_t)(row0 + ai * 128 + m * 16) * 2048 + col0 + bj * 128);
#pragma unroll
        for (int ai = 0; ai < 2; ++ai) {
#pragma unroll
            for (int m = 0; m < 4; ++m) {
                const int row = row0 + ai * 128 + m * 16; const size_t off = (size_t)row * 2048 + col0; float ss = 0.f;
#pragma unroll
                for (int bj = 0; bj < 2; ++bj) {
                    f32x4 b0, b1; unpack8(bw[ai][m][bj], b0, b1);
                    const f32x4 o0 = b0 + acc[ai][bj][m][0], o1 = b1 + acc[ai][bj][m][1];
                    if (outF) { *(f32x4*)(outF + off + bj * 128) = o0; *(f32x4*)(outF + off + bj * 128 + 4) = o1; }
                    else { *(u32x4*)(Hb + off + bj * 128) = pack8(o0, o1);
                        ss += (o0[0] * o0[0] + o0[1] * o0[1]) + (o0[2] * o0[2] + o0[3] * o0[3]) + (o1[0] * o1[0] + o1[1] * o1[1]) + (o1[2] * o1[2] + o1[3] * o1[3]); }
                }
                if (!outF) { ss += __shfl_xor(ss, 16); ss += __shfl_xor(ss, 32); if (fq == 0) atomicAdd(SS + row, ss); }
            }
        }
    }
};
struct EpiRelu2 { static constexpr bool PERM = true, HAS_MID = false; bf16_t* Hd; const float* SS;
    __device__ __forceinline__ void operator()(const AccT& acc, const Unit& u, int wr, int wc, int fr, int fq) const {
        const int row0 = u.pm * 256 + wr * 64 + fr, col0 = u.pn * 256 + wc * 32 + 8 * fq;
        float rsv[2][4];
#pragma unroll
        for (int ai = 0; ai < 2; ++ai)
#pragma unroll
            for (int m = 0; m < 4; ++m) rsv[ai][m] = SS[row0 + ai * 128 + m * 16];
#pragma unroll
        for (int ai = 0; ai < 2; ++ai)
#pragma unroll
            for (int m = 0; m < 4; ++m) {
                const float rs = rstd_of(rsv[ai][m]);
#pragma unroll
                for (int bj = 0; bj < 2; ++bj) {
                    f32x4 v0 = acc[ai][bj][m][0] * rs, v1 = acc[ai][bj][m][1] * rs;
#pragma unroll
                    for (int j = 0; j < 4; ++j) { const float a = fmaxf(v0[j], 0.f), b = fmaxf(v1[j], 0.f); v0[j] = a * a; v1[j] = b * b; }
                    *(u32x4*)(Hd + (size_t)(row0 + ai * 128 + m * 16) * DFF + col0 + bj * 128) = pack8(v0, v1);
                }
            }
    }
};

struct TrTask { const float* src; size_t sld; bf16_t* dst; size_t dld; const float* gk; };
__device__ __forceinline__ int winT_row(int n0) {
    if (n0 < 512) return n0; if (n0 < 1024) return 1536 + (n0 - 512); if (n0 < 1536) return 2048 + (n0 - 1024);
    if (n0 < 2560) return 2560 + (n0 - 1536); if (n0 < 3584) return 3584 + (n0 - 2560); if (n0 < 4608) return 512 + (n0 - 3584); return n0;
}
__device__ __forceinline__ TrTask tr_decode(const Params& p, int t) {
    const int l = t / 30720; int r = t - l * 30720;
    unsigned char* wl = p.ws + OFF_W + (size_t)l * SZ_LAYER;
    bf16_t* WinT = (bf16_t*)wl; bf16_t* W1T = (bf16_t*)(wl + SZ_WIN); bf16_t* W2T = (bf16_t*)(wl + SZ_WIN + SZ_W1); bf16_t* WoT = (bf16_t*)(wl + SZ_WIN + SZ_W1 + SZ_W2); bf16_t* WcT = (bf16_t*)(wl + SZ_WIN + SZ_W1 + SZ_W2 + SZ_WO);
    if (r < 10752) { const int kt = r / 336, nt = r - kt * 336; return TrTask{p.in[3] + (size_t)l * 2048 * 10752 + (size_t)kt * 64 * 10752 + nt * 32, 10752, WinT + (size_t)winT_row(nt * 32) * 2048 + kt * 64, 2048, p.in[2] + l * DM + kt * 64}; }
    r -= 10752;
    if (r < 8192) { const int kt = r >> 8, nt = r & 255; return TrTask{p.in[17] + (size_t)l * 2048 * 8192 + (size_t)kt * 64 * 8192 + nt * 32, 8192, W1T + (size_t)nt * 32 * 2048 + kt * 64, 2048, p.in[16] + l * DM + kt * 64}; }
    r -= 8192;
    if (r < 8192) { const int kt = r >> 6, nt = r & 63; return TrTask{p.in[18] + (size_t)l * 8192 * 2048 + (size_t)kt * 64 * 2048 + nt * 32, 2048, W2T + (size_t)nt * 32 * 8192 + kt * 64, 8192, nullptr}; }
    r -= 8192;
    if (r < 2048) { const int kt = r >> 6, nt = r & 63; return TrTask{p.in[15] + (size_t)l * 2048 * 2048 + (size_t)kt * 64 * 2048 + nt * 32, 2048, WoT + (size_t)nt * 32 * 2048 + kt * 64, 2048, nullptr}; }
    r -= 2048;
    if (r < 512) { const int kt = r >> 6, nt = r & 63; return TrTask{p.in[10] + (size_t)l * 512 * 2048 + (size_t)kt * 64 * 2048 + nt * 32, 2048, WcT + (size_t)nt * 32 * XW + 1024 + kt * 64, XW, nullptr}; }
    r -= 512;
    { const int kt = r >> 6, nt = r & 63; return TrTask{p.in[14] + (size_t)l * 1024 * 2048 + (size_t)kt * 64 * 2048 + nt * 32, 2048, WcT + (size_t)nt * 32 * XW + 1536 + kt * 64, XW, nullptr}; }
}
__device__ void ph_prep(const Params& p, LAS unsigned char* lds_in, const int WID) {
    LAS unsigned char* lds = local_lds(lds_in);
    const int tid = opaque_tid(WID), lane = tid & 63, wv = __builtin_amdgcn_readfirstlane(tid >> 6);
    LAS float* tile = (LAS float*)lds + wv * (64 * 33);
    const int ri = lane >> 3, j4 = (lane & 7) * 4, k8 = (lane & 7) * 8;
    {
        int t = blockIdx.x * 8 + wv;
        TrTask cur = tr_decode(p, t);
        f32x4 v[8], gA, gB;
#pragma unroll
        for (int q = 0; q < 8; ++q) v[q] = *(const f32x4*)(cur.src + (size_t)(q * 8 + ri) * cur.sld + j4);
        { const float* gp = cur.gk ? cur.gk : p.in[2];
#pragma unroll
          for (int q = 0; q < 4; ++q) { gA[q] = gp[q * 8 + ri]; gB[q] = gp[(q + 4) * 8 + ri]; }
          if (!cur.gk) { gA = (f32x4){1.f, 1.f, 1.f, 1.f}; gB = gA; } }
        for (; t < 2 * 30720; t += NWAVES_TOTAL) {
            const int tn = t + NWAVES_TOTAL; const bool more = tn < 2 * 30720;
            const TrTask nxt = tr_decode(p, more ? tn : t);
            f32x4 vn[8], hA, hB;
#pragma unroll
            for (int q = 0; q < 8; ++q) vn[q] = *(const f32x4*)(nxt.src + (size_t)(q * 8 + ri) * nxt.sld + j4);
            { const float* gp = nxt.gk ? nxt.gk : p.in[2];
#pragma unroll
              for (int q = 0; q < 4; ++q) { hA[q] = gp[q * 8 + ri]; hB[q] = gp[(q + 4) * 8 + ri]; }
              if (!nxt.gk) { hA = (f32x4){1.f, 1.f, 1.f, 1.f}; hB = hA; } }
#pragma unroll
            for (int q = 0; q < 8; ++q) { const int i = q * 8 + ri; const f32x4 x = v[q] * (q < 4 ? gA[q & 3] : gB[q & 3]); tile[i * 33 + j4] = x[0]; tile[i * 33 + j4 + 1] = x[1]; tile[i * 33 + j4 + 2] = x[2]; tile[i * 33 + j4 + 3] = x[3]; }
            asm volatile("s_waitcnt lgkmcnt(0)" ::: "memory"); __builtin_amdgcn_wave_barrier();
#pragma unroll
            for (int q = 0; q < 4; ++q) { const int j = q * 8 + ri; f32x4 a, b;
#pragma unroll
                for (int e = 0; e < 4; ++e) { a[e] = tile[(k8 + e) * 33 + j]; b[e] = tile[(k8 + 4 + e) * 33 + j]; }
                *(u32x4*)(cur.dst + (size_t)j * cur.dld + k8) = pack8(a, b); }
            asm volatile("s_waitcnt lgkmcnt(0)" ::: "memory"); __builtin_amdgcn_wave_barrier();
            cur = nxt; gA = hA; gB = hB;
#pragma unroll
            for (int q = 0; q < 8; ++q) v[q] = vn[q];
        }
    }
    __syncthreads();
    LAS float* wt = (LAS float*)lds;
    LAS float* ctab = wt + 512 * 16;
    LAS float* stab = ctab + 128;
    if (tid < 128) { float sn, cs; sincospif((float)tid / 64.0f, &sn, &cs); ctab[tid] = cs; stab[tid] = sn; }
    for (int t = blockIdx.x; t < 2 * 128; t += gridDim.x) {
        const int l = t >> 7, e0 = (t & 127) * 16;
        __syncthreads();
        { const float* srow = p.in[5] + (size_t)l * 512 * 2048 + (size_t)tid * 2048 + e0;
#pragma unroll
          for (int q = 0; q < 4; ++q) *(LAS f32x4*)(wt + tid * 16 + q * 4) = *(const f32x4*)(srow + q * 4); }
        __syncthreads();
        bf16_t* WcT = (bf16_t*)(p.ws + OFF_W + (size_t)l * SZ_LAYER + SZ_WIN + SZ_W1 + SZ_W2 + SZ_WO);
#pragma unroll 1
        for (int q = 0; q < 2; ++q) {
            const int kp = tid + 512 * q, g = kp >> 8, part = (kp >> 7) & 1, c = kp & 127;
            f32x4 s0 = {0.f, 0.f, 0.f, 0.f}, s1 = s0, s2 = s0, s3 = s0;
            for (int m = 0; m < 128; ++m) {
                const int idx = (c * m) & 127; const float tw = part ? -stab[idx] : ctab[idx];
                const LAS float* wr_ = wt + (g * 128 + m) * 16;
                s0 += tw * *(const LAS f32x4*)wr_; s1 += tw * *(const LAS f32x4*)(wr_ + 4); s2 += tw * *(const LAS f32x4*)(wr_ + 8); s3 += tw * *(const LAS f32x4*)(wr_ + 12);
            }
            const float sc = 0.08838834764831845f;
#pragma unroll
            for (int e = 0; e < 4; ++e) {
                WcT[(size_t)(e0 + e) * XW + kp] = (bf16_t)(cvt_pk_bf16(s0[e] * sc, 0.f) & 0xffff);
                WcT[(size_t)(e0 + 4 + e) * XW + kp] = (bf16_t)(cvt_pk_bf16(s1[e] * sc, 0.f) & 0xffff);
                WcT[(size_t)(e0 + 8 + e) * XW + kp] = (bf16_t)(cvt_pk_bf16(s2[e] * sc, 0.f) & 0xffff);
                WcT[(size_t)(e0 + 12 + e) * XW + kp] = (bf16_t)(cvt_pk_bf16(s3[e] * sc, 0.f) & 0xffff);
            }
        }
    }
    bf16_t* Fm = (bf16_t*)(p.ws + OFF_FM);
    for (int it = blockIdx.x * NTHREADS + tid; it < 4096 * 256; it += gridDim.x * NTHREADS) {
        const int row = it >> 8, t0 = (it & 255) * 8, s = row & 2047, part = row >> 11;
        f32x4 a, b;
#pragma unroll
        for (int j = 0; j < 8; ++j) { float sn, cs; sincospif((float)((s * (t0 + j)) & 2047) / 1024.0f, &sn, &cs); const float v = (part ? sn : cs) * 0.022097086912079608f; if (j < 4) a[j] = v; else b[j - 4] = v; }
        *(u32x4*)(Fm + (size_t)row * 2048 + t0) = pack8(a, b);
    }
}

__device__ void ph_cvt(const float* __restrict__ x, bf16_t* __restrict__ H, float* __restrict__ SS, const int WID) {
    const int tid = opaque_tid(WID), lane = tid & 63, gw = blockIdx.x * 8 + __builtin_amdgcn_readfirstlane(tid >> 6);
    for (int row = gw * 2; row < CH; row += NWAVES_TOTAL * 2) {
        f32x4 v[2][8]; float ss[2] = {0.f, 0.f};
#pragma unroll
        for (int r = 0; r < 2; ++r)
#pragma unroll
            for (int i = 0; i < 8; ++i) v[r][i] = *(const f32x4*)(x + (size_t)(row + r) * DM + (i * 64 + lane) * 4);
#pragma unroll
        for (int r = 0; r < 2; ++r) {
#pragma unroll
            for (int i = 0; i < 8; ++i) ss[r] += v[r][i][0] * v[r][i][0] + v[r][i][1] * v[r][i][1] + v[r][i][2] * v[r][i][2] + v[r][i][3] * v[r][i][3];
#pragma unroll
            for (int o = 32; o >= 1; o >>= 1) ss[r] += __shfl_xor(ss[r], o);
#pragma unroll
            for (int i = 0; i < 8; ++i) { u32x2 w; w.x = cvt_pk_bf16(v[r][i][0], v[r][i][1]); w.y = cvt_pk_bf16(v[r][i][2], v[r][i][3]); *(u32x2*)(H + (size_t)(row + r) * DM + (i * 64 + lane) * 4) = w; }
            if (lane == 0) SS[row + r] = ss[r];
        }
    }
}
__device__ __forceinline__ void zero_rows(float* SS, const int WID) { for (int i = blockIdx.x * NTHREADS + opaque_tid(WID); i < CH; i += NBLOCKS * NTHREADS) SS[i] = 0.f; }

__device__ void ph_conv(const bf16_t* Z, bf16_t* X, const float* dw, const float* db, const float* lng, const float* lnb, int S, LAS unsigned char* lds_in, const int WID) {
    LAS unsigned char* lds = local_lds(lds_in);
    LAS bf16_t* ut = (LAS bf16_t*)lds;
    LAS float* yt = (LAS float*)(lds + 65536);
    const int tid = opaque_tid(WID), lane = tid & 63, wid = __builtin_amdgcn_readfirstlane(tid >> 6);
    float w[31];
#pragma unroll
    for (int j = 0; j < 31; ++j) w[j] = dw[j * 512 + tid];
    const float bias = db[tid];
    const f32x4 lg0 = *(const f32x4*)(lng + lane * 8), lg1 = *(const f32x4*)(lng + lane * 8 + 4), lb0 = *(const f32x4*)(lnb + lane * 8), lb1 = *(const f32x4*)(lnb + lane * 8 + 4);
    for (int tl = blockIdx.x; tl < CH / 32; tl += gridDim.x) {
        const int t0 = tl * 32, ss0 = (t0 / S) * S, se = ss0 + S;
        __syncthreads();
        {
            u32x4 aw[8], gw[8];
#pragma unroll
            for (int k = 0; k < 8; ++k) {
                const int idx = min(tid + k * NTHREADS, 62 * 64 - 1), rr = idx >> 6, c8 = (idx & 63) * 8, tok = min(max(t0 - 15 + rr, ss0), se - 1);
                aw[k] = *(const u32x4*)(Z + (size_t)tok * ZW + c8); gw[k] = *(const u32x4*)(Z + (size_t)tok * ZW + 512 + c8);
            }
#pragma unroll
            for (int k = 0; k < 8; ++k) {
                const int idx = tid + k * NTHREADS, rr = idx >> 6, c8 = (idx & 63) * 8, tok = t0 - 15 + rr;
                const float keep = (tok >= ss0 && tok < se) ? 1.0f : 0.0f;
                f32x4 a0, a1, g0, g1; unpack8(aw[k], a0, a1); unpack8(gw[k], g0, g1);
#pragma unroll
                for (int j = 0; j < 4; ++j) { a0[j] *= sigmoidf_(g0[j]) * keep; a1[j] *= sigmoidf_(g1[j]) * keep; }
                if (idx < 62 * 64) *(LAS u32x4*)(ut + rr * 512 + c8) = pack8(a0, a1);
            }
        }
        __syncthreads();
        for (int tt = 0; tt < 32; tt += 4) {
            float a0 = bias, a1 = bias, a2 = bias, a3 = bias;
#pragma unroll
            for (int jj = 0; jj < 34; ++jj) {
                const float xv = bf2f(ut[(tt + jj) * 512 + tid]);
                if (jj < 31) a0 += w[jj < 31 ? jj : 0] * xv;
                if (jj >= 1 && jj < 32) a1 += w[(jj >= 1 && jj < 32) ? jj - 1 : 0] * xv;
                if (jj >= 2 && jj < 33) a2 += w[(jj >= 2 && jj < 33) ? jj - 2 : 0] * xv;
                if (jj >= 3) a3 += w[jj >= 3 ? jj - 3 : 0] * xv;
            }
            yt[tt * 512 + tid] = a0; yt[(tt + 1) * 512 + tid] = a1; yt[(tt + 2) * 512 + tid] = a2; yt[(tt + 3) * 512 + tid] = a3;
        }
        __syncthreads();
#pragma unroll
        for (int q = 0; q < 4; ++q) {
            const int tt = wid * 4 + q;
            const f32x4 y0 = *(const LAS f32x4*)(yt + tt * 512 + lane * 8), y1 = *(const LAS f32x4*)(yt + tt * 512 + lane * 8 + 4);
            float s = (y0[0] + y0[1]) + (y0[2] + y0[3]) + (y1[0] + y1[1]) + (y1[2] + y1[3]);
#pragma unroll
            for (int o = 32; o >= 1; o >>= 1) s += __shfl_xor(s, o);
            const float mu = s * (1.0f / 512.0f);
            const f32x4 d0 = y0 - mu, d1 = y1 - mu;
            float qv = (d0[0] * d0[0] + d0[1] * d0[1]) + (d0[2] * d0[2] + d0[3] * d0[3]) + (d1[0] * d1[0] + d1[1] * d1[1]) + (d1[2] * d1[2] + d1[3] * d1[3]);
#pragma unroll
            for (int o = 32; o >= 1; o >>= 1) qv += __shfl_xor(qv, o);
            const float rstd = rsqrtf(qv * (1.0f / 512.0f) + EPS);
            f32x4 v0 = d0 * rstd * lg0 + lb0, v1 = d1 * rstd * lg1 + lb1;
#pragma unroll
            for (int j = 0; j < 4; ++j) { v0[j] *= sigmoidf_(v0[j]); v1[j] *= sigmoidf_(v1[j]); }
            *(u32x4*)(X + (size_t)(t0 + tt) * XW + 1024 + lane * 8) = pack8(v0, v1);
        }
    }
    __syncthreads();
}

__device__ void ph_qknorm(bf16_t* Z, const float* qg, const float* kg, const int WID) {
    const int tid = opaque_tid(WID), lane = tid & 63, gw = blockIdx.x * 8 + __builtin_amdgcn_readfirstlane(tid >> 6);
    f32x4 qgv[4], kgv[4];
#pragma unroll
    for (int e = 0; e < 4; ++e) { qgv[e] = *(const f32x4*)(qg + (lane & 7) * 16 + e * 4); kgv[e] = *(const f32x4*)(kg + (lane & 7) * 16 + e * 4); }
    for (int it0 = gw * 4; it0 < 2 * CH; it0 += NWAVES_TOTAL * 4) {
        u32x4 w0[4], w1[4];
#pragma unroll
        for (int q = 0; q < 4; ++q) { const int item = it0 + q; const bf16_t* ptr = Z + (size_t)(item >> 1) * ZW + ZQ + (item & 1) * 1024 + lane * 16; w0[q] = *(const u32x4*)ptr; w1[q] = *(const u32x4*)(ptr + 8); }
#pragma unroll
        for (int q = 0; q < 4; ++q) {
            const int item = it0 + q, isk = item & 1;
            bf16_t* ptr = Z + (size_t)(item >> 1) * ZW + ZQ + isk * 1024 + lane * 16;
            f32x4 a0, a1, a2, a3; unpack8(w0[q], a0, a1); unpack8(w1[q], a2, a3);
            float ss = 0.f;
#pragma unroll
            for (int j = 0; j < 4; ++j) ss += a0[j] * a0[j] + a1[j] * a1[j] + a2[j] * a2[j] + a3[j] * a3[j];
            ss += __shfl_xor(ss, 1); ss += __shfl_xor(ss, 2); ss += __shfl_xor(ss, 4);
            const float rstd = rsqrtf(ss * (1.0f / 128.0f) + EPS) * (isk ? 1.0f : 0.08838834764831845f);
            const f32x4 g0 = isk ? kgv[0] : qgv[0], g1 = isk ? kgv[1] : qgv[1], g2 = isk ? kgv[2] : qgv[2], g3 = isk ? kgv[3] : qgv[3];
            *(u32x4*)ptr = pack8(a0 * rstd * g0, a1 * rstd * g1); *(u32x4*)(ptr + 8) = pack8(a2 * rstd * g2, a3 * rstd * g3);
        }
    }
}

template <int SHIFT>
__device__ __forceinline__ void attn_pair(const bf16_t* Z, const bf16_t* TT, bf16_t* X, const LAS float* rp, int S, int b, int h, int r0, int rsA, int j, int lane, float kbound, float bmax, LAS u32x4* pl) {
    constexpr int NR = 8 + SHIFT;
    const int g = lane >> 4, n = lane & 15;
    const int kk0 = (n >> 2) * 8 + (n & 3);
    const int c0 = (j == 0) ? 0 : (j == 1) ? 8 : (j == 2) ? 24 : 32;
    const int tokq = b * S + r0 * 64 + j * 16 + n;
    const int tok0 = b * S + rsA * 64 + c0;
    const char* qU = (const char*)Z + ((size_t)(b * S + r0 * 64 + j * 16) * ZW + ZQ + h * 128) * 2; const unsigned qL = (unsigned)(n * ZW + g * 8) * 2u;
    const char* kU = (const char*)Z + ((size_t)tok0 * ZW + ZK + h * 128) * 2; const unsigned kL = (unsigned)(kk0 * ZW + g * 8) * 2u;
    const char* vU = (const char*)TT + ((size_t)(512 + h * 128) * CH + tok0) * 2; const unsigned vL = (unsigned)(n * CH + g * 8) * 2u;
    bf16x8 qA[4], qB[4];
#pragma unroll
    for (int ks = 0; ks < 4; ++ks) { qA[ks] = *(const bf16x8*)(qU + ks * 64 + qL); qB[ks] = *(const bf16x8*)(qU + (size_t)64 * ZW * 2 + ks * 64 + qL); }
    bf16x8 kf[2][8];
#define ATT_LOADK(buf, i) do { const char* _k = kU + (size_t)(i) * 64 * ZW * 2; _Pragma("unroll") for (int ks = 0; ks < 4; ++ks) { kf[buf][ks] = *(const bf16x8*)(_k + ks * 64 + kL); kf[buf][4 + ks] = *(const bf16x8*)(_k + (size_t)4 * ZW * 2 + ks * 64 + kL); } } while (0)
    ATT_LOADK(0, 0); ATT_LOADK(1, 1);
    float ssA = 0.f, ssB = 0.f;
#pragma unroll
    for (int ks = 0; ks < 4; ++ks) { u32x4 wa, wb; __builtin_memcpy(&wa, &qA[ks], 16); __builtin_memcpy(&wb, &qB[ks], 16); f32x4 a0, a1, b0, b1; unpack8(wa, a0, a1); unpack8(wb, b0, b1);
#pragma unroll
        for (int e = 0; e < 4; ++e) { ssA += a0[e] * a0[e] + a1[e] * a1[e]; ssB += b0[e] * b0[e] + b1[e] * b1[e]; } }
    ssA += __shfl_xor(ssA, 16); ssA += __shfl_xor(ssA, 32); ssB += __shfl_xor(ssB, 16); ssB += __shfl_xor(ssB, 32);
    const float CA = sqrtf(ssA) * kbound + bmax, CB = sqrtf(ssB) * kbound + bmax;
    const int c = j * 16 + n, start = min(max(c - 8, 0), 48);
    float lA = 0.f, lB = 0.f;
#define ATT_SCORE(QF, CC, DR, PDST, LSUM) do { \
        f32x4 s0 = {0.f, 0.f, 0.f, 0.f}, s1 = s0; \
        _Pragma("unroll") for (int ks = 0; ks < 4; ++ks) { s0 = __builtin_amdgcn_mfma_f32_16x16x32_bf16(kf[i % 2][ks], QF[ks], s0, 0, 0, 0); s1 = __builtin_amdgcn_mfma_f32_16x16x32_bf16(kf[i % 2][4 + ks], QF[ks], s1, 0, 0, 0); } \
        const LAS float* bp = rp + (h * 15 + (DR)) * 31; \
        _Pragma("unroll") for (int jj = 0; jj < 4; ++jj) { \
            const int kc0 = c0 + g * 8 + jj, kc1 = kc0 + 4; \
            const bool v0 = (kc0 >= start) && (kc0 < start + 16), v1 = (kc1 >= start) && (kc1 < start + 16); \
            const float p0 = v0 ? __expf(s0[jj] + bp[min(max(kc0 - c + 15, 0), 30)] - (CC)) : 0.f; \
            const float p1 = v1 ? __expf(s1[jj] + bp[min(max(kc1 - c + 15, 0), 30)] - (CC)) : 0.f; \
            s0[jj] = p0; s1[jj] = p1; LSUM += p0 + p1; } \
        pl[(PDST) * 64] = pack8(s0, s1); } while (0)
#pragma unroll
    for (int i = 0; i < NR; ++i) {
        if (i < 8) ATT_SCORE(qA, CA, (rsA + i) - r0 + 7, i, lA);
        __builtin_amdgcn_sched_barrier(0);
        if (i >= SHIFT && i - SHIFT < 8) ATT_SCORE(qB, CB, (rsA + i) - (r0 + 1) + 7, 8 + i - SHIFT, lB);
        __builtin_amdgcn_sched_barrier(0);
        if (i + 2 < NR) ATT_LOADK(i % 2, i + 2);
        asm volatile("" ::: "memory"); __builtin_amdgcn_sched_barrier(0);
    }
#undef ATT_SCORE
#undef ATT_LOADK
    bf16x8 vf[2][8];
#define ATT_LOADV(buf, i) do { const char* _v = vU + (i) * 128; _Pragma("unroll") for (int dt = 0; dt < 8; ++dt) vf[buf][dt] = *(const bf16x8*)(_v + (size_t)dt * 16 * CH * 2 + vL); } while (0)
    ATT_LOADV(0, 0); ATT_LOADV(1, 1);
    lA += __shfl_xor(lA, 16); lA += __shfl_xor(lA, 32); lB += __shfl_xor(lB, 16); lB += __shfl_xor(lB, 32);
    const float invA = 1.0f / lA, invB = 1.0f / lB;
    f32x4 oA[8], oB[8];
#pragma unroll
    for (int dt = 0; dt < 8; ++dt) { oA[dt] = (f32x4){0.f, 0.f, 0.f, 0.f}; oB[dt] = (f32x4){0.f, 0.f, 0.f, 0.f}; }
#pragma unroll
    for (int i = 0; i < NR; ++i) {
        if (i < 8) { const u32x4 pw = pl[i * 64]; bf16x8 pb; __builtin_memcpy(&pb, &pw, 16);
#pragma unroll
            for (int dt = 0; dt < 8; ++dt) oA[dt] = __builtin_amdgcn_mfma_f32_16x16x32_bf16(vf[i % 2][dt], pb, oA[dt], 0, 0, 0); }
        if (i >= SHIFT && i - SHIFT < 8) { const u32x4 pw = pl[(8 + i - SHIFT) * 64]; bf16x8 pb; __builtin_memcpy(&pb, &pw, 16);
#pragma unroll
            for (int dt = 0; dt < 8; ++dt) oB[dt] = __builtin_amdgcn_mfma_f32_16x16x32_bf16(vf[i % 2][dt], pb, oB[dt], 0, 0, 0); }
        __builtin_amdgcn_sched_barrier(0);
        if (i + 2 < NR) ATT_LOADV(i % 2, i + 2);
        asm volatile("" ::: "memory"); __builtin_amdgcn_sched_barrier(0);
    }
#undef ATT_LOADV
    bf16_t* op = X + (size_t)tokq * XW + 1536 + h * 128 + g * 4;
#pragma unroll
    for (int dt = 0; dt < 8; ++dt) {
        u32x2 w; w.x = cvt_pk_bf16(oA[dt][0] * invA, oA[dt][1] * invA); w.y = cvt_pk_bf16(oA[dt][2] * invA, oA[dt][3] * invA); *(u32x2*)(op + dt * 16) = w;
        u32x2 v; v.x = cvt_pk_bf16(oB[dt][0] * invB, oB[dt][1] * invB); v.y = cvt_pk_bf16(oB[dt][2] * invB, oB[dt][3] * invB); *(u32x2*)(op + (size_t)64 * XW + dt * 16) = v;
    }
}
__device__ void ph_attn(const bf16_t* Z, const bf16_t* TT, bf16_t* X, const float* rpb, const float* kg, int S, int rows, int nb, LAS unsigned char* lds_in, const int WID) {
    LAS unsigned char* lds = local_lds(lds_in);
    const int tid = opaque_tid(WID), lane = tid & 63;
    LAS float* rp = (LAS float*)lds;
    __syncthreads();
    for (int i = tid; i < 8 * 15 * 31; i += NTHREADS) rp[i] = rpb[i];
    __syncthreads();
    float bmax = 0.f;
    for (int i = lane; i < 8 * 15 * 31; i += 64) bmax = fmaxf(bmax, fabsf(rp[i]));
    float gmax = fmaxf(fabsf(kg[lane]), fabsf(kg[lane + 64]));
#pragma unroll
    for (int o = 32; o >= 1; o >>= 1) { bmax = fmaxf(bmax, __shfl_xor(bmax, o)); gmax = fmaxf(gmax, __shfl_xor(gmax, o)); }
    const float kbound = gmax * 11.313708499f * 1.01f;
    const int vblk = (blockIdx.x & 7) * (NBLOCKS / 8) + (blockIdx.x >> 3);
    const int gw = vblk * 8 + __builtin_amdgcn_readfirstlane(tid >> 6);
    LAS u32x4* pl = (LAS u32x4*)(lds + 15360) + __builtin_amdgcn_readfirstlane(tid >> 6) * (16 * 64) + lane;
    const int hrows = rows >> 1, total = nb * 8 * hrows * 4;
    for (int u = gw; u < total; u += NWAVES_TOTAL) {
        const int j = u & 3, rr = u >> 2, rpi = rr % hrows, bh = rr / hrows, h = bh & 7, b = bh >> 3;
        const int r0 = 2 * rpi, rsA = min(max(r0 - 4, 0), rows - 8), rsB = min(max(r0 - 3, 0), rows - 8);
        if (rsB != rsA) attn_pair<1>(Z, TT, X, rp, S, b, h, r0, rsA, j, lane, kbound, bmax, pl);
        else attn_pair<0>(Z, TT, X, rp, S, b, h, r0, rsA, j, lane, kbound, bmax, pl);
    }
}

__device__ void ph_combine(const bf16_t* E, bf16_t* X, const int WID) {
    const int tid = opaque_tid(WID), lane = tid & 63, gw = blockIdx.x * 8 + __builtin_amdgcn_readfirstlane(tid >> 6);
    const int gq = lane >> 4, c8 = (lane & 15) * 8;
    for (int item = gw; item < CH; item += NWAVES_TOTAL) {
        const int b = item >> 13, k = item & 8191, m = k & 2047;
        f32x4 xc0 = {0.f, 0.f, 0.f, 0.f}, xc1 = xc0, xs0 = xc0, xs1 = xc0;
#pragma unroll
        for (int r = 0; r < 4; ++r) {
            float sn, cs; sincospif((float)((r * k) & 8191) / 4096.0f, &sn, &cs);
            const bf16_t* ep = E + (size_t)((b * 4 + r) * 2048 + m) * 1024 + gq * 256 + c8;
            const u32x4 cw = *(const u32x4*)ep, sw = *(const u32x4*)(ep + 128);
            f32x4 ec0, ec1, es0, es1; unpack8(cw, ec0, ec1); unpack8(sw, es0, es1);
            xc0 += cs * ec0 - sn * es0; xc1 += cs * ec1 - sn * es1;
            xs0 += cs * es0 + sn * ec0; xs1 += cs * es1 + sn * ec1;
        }
        bf16_t* xp = X + (size_t)item * XW + gq * 256 + c8;
        *(u32x4*)xp = pack8(xc0 * 0.5f, xc1 * 0.5f); *(u32x4*)(xp + 128) = pack8(xs0 * 0.5f, xs1 * 0.5f);
    }
}


#define XB_TMO      128
#define XB_XCNT(j)  (256  + 64 * (j))
#define XB_XSUB(j)  (1280 + 64 * (j))
#define XB_XGEN(j)  (2304 + 64 * (j))
#define XB_TOP      3328
#define XB_TOPGEN   3392
#define XCD_BAR_WORDS 3456
#define XB_SPIN_CAP (1u << 20)
__device__ __forceinline__ unsigned xb_ld(unsigned* p)              { return __hip_atomic_load(p, __ATOMIC_RELAXED, __HIP_MEMORY_SCOPE_AGENT); }
__device__ __forceinline__ unsigned xb_add(unsigned* p, unsigned v) { return __hip_atomic_fetch_add(p, v, __ATOMIC_RELAXED, __HIP_MEMORY_SCOPE_AGENT); }
__device__ __forceinline__ unsigned xb_xcc_id() { return (unsigned)__builtin_amdgcn_s_getreg((3 << 11) | 20) & 0xFu; }
#define XB_SPIN(cond, bar) do { unsigned _sp = 0; while (cond) { __builtin_amdgcn_s_sleep(1); \
    if ((++_sp & 255u) == 0u) { if (xb_ld(&(bar)[XB_TMO])) break; if (_sp > XB_SPIN_CAP) { atomicAdd(&(bar)[XB_TMO], 1u); break; } } } } while (0)
struct XcdBarrier { unsigned* bar; unsigned x; volatile LAS unsigned* st; };
__device__ __forceinline__ XcdBarrier xcd_barrier_post(unsigned* bar, volatile LAS unsigned* st) {
    XcdBarrier b; b.bar = bar; b.x = xb_xcc_id(); b.st = st;
    if (threadIdx.x == 0) (void)xb_add(&bar[XB_XCNT(b.x)], 1u);
    return b;
}
__device__ __forceinline__ void xcd_barrier_complete(unsigned* bar, unsigned x, unsigned& nloc, unsigned& nx) {
    const unsigned G = gridDim.x * gridDim.y * gridDim.z;
    unsigned sum, cnt, mine, sp = 0u;
    for (;;) {
        sum = 0u; cnt = 0u; mine = 0u;
#pragma unroll
        for (unsigned j = 0; j < 16; ++j) { const unsigned c = xb_ld(&bar[XB_XCNT(j)]); sum += c; cnt += (c > 0u) ? 1u : 0u; }
        mine = xb_ld(&bar[XB_XCNT(x)]);
        if (sum == G) break;
        __builtin_amdgcn_s_sleep(1);
        if ((++sp & 255u) == 0u) { if (xb_ld(&bar[XB_TMO])) break; if (sp > XB_SPIN_CAP) { atomicAdd(&bar[XB_TMO], 1u); break; } }
    }
    nloc = mine > 0u ? mine : 1u; nx = cnt > 0u ? cnt : 1u;
}
__device__ __forceinline__ void xcd_barrier(const XcdBarrier& b, const int WID) {
    asm volatile("s_waitcnt vmcnt(0)" ::: "memory");
    __syncthreads();
    if (opaque_tid(WID) == 0) {
        unsigned* bar = b.bar; asm volatile("" : "+s"(bar));
        __builtin_amdgcn_s_waitcnt(0);
        unsigned nloc = b.st[0], nx = b.st[1];
        if (nloc == 0u) { xcd_barrier_complete(bar, b.x, nloc, nx); b.st[0] = nloc; b.st[1] = nx; }
        const unsigned old = xb_add(&bar[XB_XSUB(b.x)], 1u);
        const unsigned gen = old / nloc;
        if (old + 1u == (gen + 1u) * nloc) {
            __builtin_amdgcn_fence(__ATOMIC_RELEASE, "agent");
            asm volatile("s_waitcnt vmcnt(0)" ::: "memory");
            const unsigned og = xb_add(&bar[XB_TOP], 1u);
            const unsigned tg = og / nx;
            if (og + 1u == (tg + 1u) * nx) xb_add(&bar[XB_TOPGEN], 1u);
            else XB_SPIN(xb_ld(&bar[XB_TOPGEN]) == tg, bar);
            __builtin_amdgcn_fence(__ATOMIC_ACQUIRE, "agent");
            xb_add(&bar[XB_XGEN(b.x)], 1u);
            asm volatile("s_waitcnt vmcnt(0)" ::: "memory");
        } else {
            XB_SPIN(xb_ld(&bar[XB_XGEN(b.x)]) == gen, bar);
            __builtin_amdgcn_fence(__ATOMIC_ACQUIRE, "agent");
            asm volatile("s_waitcnt vmcnt(0)" ::: "memory");
        }
    }
    __syncthreads();
}

constexpr int STEPS = 15;
constexpr int N_PHASES = 1 + NCHUNK * STEPS;

__global__ void __launch_bounds__(NTHREADS, 2) fwd_kernel(Params p) {
    extern __shared__ __attribute__((aligned(16))) unsigned char lds_raw[];
    LAS unsigned char* lds = (LAS unsigned char*)lds_raw;
    const int G = gridDim.x, cblk = blockIdx.x;
    const int WID = __builtin_amdgcn_readfirstlane((int)threadIdx.x >> 6);
    if (threadIdx.x < 4) ((LAS unsigned*)(lds + LDS_BAR_OFF))[threadIdx.x] = 0u;
    __syncthreads();
    const XcdBarrier xbar = xcd_barrier_post((unsigned*)(p.ws + OFF_BAR), (volatile LAS unsigned*)(lds + LDS_BAR_OFF));
    unsigned char* ws = p.ws;
    bf16_t* Fm = (bf16_t*)(ws + OFF_FM); bf16_t* H = (bf16_t*)(ws + OFF_H); bf16_t* Z = (bf16_t*)(ws + OFF_Z); bf16_t* HID = Z;
    bf16_t* TT = (bf16_t*)(ws + OFF_TT); bf16_t* E = (bf16_t*)(ws + OFF_E); bf16_t* X = (bf16_t*)(ws + OFF_X); bf16_t* M = (bf16_t*)(ws + OFF_M);
    ph_prep(p, lds, WID);
    asm volatile("" ::: "memory");
    cg::this_grid().sync();
    for (int phi = 1; phi < N_PHASES; ++phi) {
        int ph = phi, cb = cblk, Gv = G; asm volatile("" : "+s"(ph), "+s"(cb), "+s"(Gv));
        {
            const int q = ph - 1, chunk = q / STEPS, step = q % STEPS, layer = step >= 8 ? 1 : 0, sub = step == 0 ? 0 : (step - 1) % 7 + 1;
            const int sample = chunk == 2, S = sample ? 8192 : 2048, rows = S / 64, nb = CH / S;
            const unsigned char* wl = ws + OFF_W + (size_t)layer * SZ_LAYER;
            const char* WinT = (const char*)wl; const char* W1T = (const char*)(wl + SZ_WIN); const char* W2T = (const char*)(wl + SZ_WIN + SZ_W1);
            const char* WoT = (const char*)(wl + SZ_WIN + SZ_W1 + SZ_W2); const char* WcT = (const char*)(wl + SZ_WIN + SZ_W1 + SZ_W2 + SZ_WO);
            float* xout = p.out + (size_t)chunk * CH * DM;
            const float* xin = layer == 0 ? (sample ? p.in[1] : p.in[0] + (size_t)chunk * CH * DM) : xout;
            float* SS1 = (float*)(ws + OFF_SS1); float* SS2 = (float*)(ws + OFF_SS2);
            switch (sub) {
            case 0: ph_cvt(xin, H, SS1, WID); break;
            case 1: { zero_rows(SS2, WID); SchedB Sc{(const char*)H, WinT, Gv, cb}; EpiB Ep{Z, TT, p.in[4] + layer * 6144, SS1, sample}; pg8::gemm_phase(lds, 2048, 2048, Sc, Ep, WID); } break;
            case 2: { SchedDFT Sc{(const char*)Fm, (const char*)TT, Gv, cb}; EpiDFT Ep{X, E, sample}; pg8::gemm_phase(lds, 2048, CH, Sc, Ep, WID);
                      __syncthreads();
                      ph_conv(Z, X, p.in[6] + layer * 31 * 512, p.in[7] + layer * 512, p.in[8] + layer * 512, p.in[9] + layer * 512, S, lds, WID);
                      ph_qknorm(Z, p.in[11] + layer * 128, p.in[12] + layer * 128, WID); } break;
            case 3: { int reps = (PROBE_DUP == 3) ? 2 : 1; asm volatile("" : "+s"(reps)); for (int rep = 0; rep < reps; ++rep) { ph_attn(Z, TT, X, p.in[13] + layer * 8 * 15 * 31, p.in[12] + layer * 128, S, rows, nb, lds, WID); if (sample) ph_combine(E, X, WID); asm volatile("" ::: "memory"); } } break;
            case 4: { SchedPlain Sc{(const char*)X, WcT, 64, 8, XW, XW, 40, Gv, cb}; EpiMrg2 Ep{Z, M}; pg8::gemm_phase(lds, XW, XW, Sc, Ep, WID); } break;
            case 5: { zero_rows(SS1, WID); SchedPlain Sc{(const char*)M, WoT, 64, 8, 2048, 2048, 32, Gv, cb}; EpiRes Ep{H, (float*)nullptr, SS2}; pg8::gemm_phase(lds, 2048, 2048, Sc, Ep, WID); } break;
            case 6: { SchedPlain Sc{(const char*)H, W1T, 64, 32, 2048, 2048, 32, Gv, cb}; EpiRelu2 Ep{HID, SS2}; pg8::gemm_phase(lds, 2048, 2048, Sc, Ep, WID); } break;
            case 7: { SchedPlain Sc{(const char*)HID, W2T, 64, 8, 8192, 8192, 128, Gv, cb}; EpiRes Ep{H, layer == 0 ? (float*)nullptr : xout, SS1}; pg8::gemm_phase(lds, 8192, 8192, Sc, Ep, WID); } break;
            }
        }
        asm volatile("" ::: "memory");
        if (phi + 1 < N_PHASES) { xcd_barrier(xbar, WID); for (int e = 0; e < PROBE_SYNCS; ++e) xcd_barrier(xbar, WID); }
    }
}

extern "C" void kernel_launch(void* const* d_in, const int* in_sizes, int n_in, void* d_out, int out_size, void* d_ws, size_t ws_size, hipStream_t stream) {
    static int ready = 0;
    if (!ready) {
        if (n_in != 19 || ws_size < WS_END) { fprintf(stderr, "kernel_launch: unexpected n_in %d / ws_size %zu (need %zu)\n", n_in, ws_size, (size_t)WS_END); ready = -1; return; }
        if (hipFuncSetAttribute((const void*)fwd_kernel, hipFuncAttributeMaxDynamicSharedMemorySize, LDS_BYTES) != hipSuccess) { fprintf(stderr, "kernel_launch: hipFuncSetAttribute failed\n"); ready = -1; return; }
        int per_cu = 0;
        if (hipOccupancyMaxActiveBlocksPerMultiprocessor(&per_cu, (const void*)fwd_kernel, NTHREADS, LDS_BYTES) != hipSuccess || per_cu < 1) fprintf(stderr, "kernel_launch: occupancy query says %d blocks per CU\n", per_cu);
        (void)hipGetLastError();
        ready = 1;
    }
    if (ready < 0) return;
    if (hipMemsetAsync((char*)d_ws + OFF_BAR, 0, BAR_BYTES, stream) != hipSuccess) { fprintf(stderr, "kernel_launch: memset failed\n"); return; }
    Params p{};
    for (int i = 0; i < 19; ++i) p.in[i] = (const float*)d_in[i];
    p.out = (float*)d_out; p.ws = (unsigned char*)d_ws;
#if MODE_MULTI
    for (int ph = 0; ph < N_PHASES; ++ph) { p.ph_lo = ph; p.ph_hi = ph + 1; hipLaunchKernelGGL(fwd_kernel, dim3(NBLOCKS), dim3(NTHREADS), LDS_BYTES, stream, p); }
#else
    p.ph_lo = 0; p.ph_hi = N_PHASES;
    void* args[] = {&p};
    hipError_t e = hipLaunchCooperativeKernel((const void*)fwd_kernel, dim3(NBLOCKS), dim3(NTHREADS), args, LDS_BYTES, stream);
    if (e != hipSuccess) fprintf(stderr, "cooperative launch failed: %s\n", hipGetErrorString(e));
#endif
}
```

```cpp
#include <hip/hip_runtime.h>
#include <hip/hip_cooperative_groups.h>
#include <cstdio>
namespace cg = cooperative_groups;

#ifndef PROBE_DUP
#define PROBE_DUP -1
#endif
#ifndef PROBE_SYNCS
#define PROBE_SYNCS 0
#endif
#ifndef MODE_MULTI
#define MODE_MULTI 0
#endif

#define LAS __attribute__((address_space(3)))
typedef unsigned short bf16_t;
typedef short bf16x8 __attribute__((ext_vector_type(8)));
typedef float f32x4 __attribute__((ext_vector_type(4)));
typedef unsigned u32x4 __attribute__((ext_vector_type(4)));
typedef unsigned u32x2 __attribute__((ext_vector_type(2)));

constexpr int DM = 2048, CH = 16384, NCHUNK = 3, DFF = 8192;
constexpr int ZW = 9216;
constexpr int ZQ = 1024, ZK = 2048, ZG = 3072;
constexpr int XW = 2560;
constexpr float EPS = 1e-6f;
constexpr int NTHREADS = 512, NBLOCKS = 256, NWAVES_TOTAL = 2048;
constexpr int LDS_BAR_OFF = 15360 + 131072;
constexpr int LDS_BYTES = LDS_BAR_OFF + 16;

constexpr size_t SZ_WIN = (size_t)10752 * 2048 * 2, SZ_W1 = (size_t)8192 * 2048 * 2, SZ_W2 = SZ_W1, SZ_WO = (size_t)2048 * 2048 * 2, SZ_WCAT = (size_t)2048 * XW * 2;
constexpr size_t SZ_LAYER = SZ_WIN + SZ_W1 + SZ_W2 + SZ_WO + SZ_WCAT;
constexpr size_t OFF_W = 0;
constexpr size_t OFF_FM = OFF_W + 2 * SZ_LAYER;
constexpr size_t OFF_H = OFF_FM + (size_t)4096 * 2048 * 2;
constexpr size_t OFF_Z = OFF_H + (size_t)CH * 2048 * 2;
constexpr size_t OFF_TT = OFF_Z + (size_t)CH * ZW * 2;
constexpr size_t OFF_E = OFF_TT + (size_t)1536 * CH * 2;
constexpr size_t OFF_X = OFF_E + (size_t)CH * 1024 * 2;
constexpr size_t OFF_M = OFF_X + (size_t)CH * XW * 2;
constexpr size_t OFF_BAR = OFF_M + (size_t)CH * 2048 * 2;
constexpr size_t BAR_BYTES = 16384;
constexpr size_t OFF_SS1 = OFF_BAR + BAR_BYTES;
constexpr size_t OFF_SS2 = OFF_SS1 + (size_t)CH * 4;
constexpr size_t WS_END = OFF_SS2 + (size_t)CH * 4;

struct Params { const float* in[19]; float* out; unsigned char* ws; int ph_lo, ph_hi; };

__device__ __forceinline__ int opaque_tid(int wid) { int wv_ = wid; asm volatile("" : "+v"(wv_)); wv_ = __builtin_amdgcn_readfirstlane(wv_); unsigned ones = ~0u; asm volatile("" : "+s"(ones)); int t = (wv_ << 6) | (int)__builtin_amdgcn_mbcnt_hi(ones, __builtin_amdgcn_mbcnt_lo(ones, 0u)); asm volatile("" : "+v"(t)); return t; }
__device__ __forceinline__ LAS unsigned char* local_lds(LAS unsigned char* l) { unsigned u = (unsigned)(size_t)l; asm volatile("" : "+s"(u)); return (LAS unsigned char*)(size_t)u; }
__device__ __forceinline__ unsigned cvt_pk_bf16(float lo, float hi) { unsigned r; asm("v_cvt_pk_bf16_f32 %0, %1, %2" : "=v"(r) : "v"(lo), "v"(hi)); return r; }
__device__ __forceinline__ float bf_lo(unsigned w) { return __uint_as_float(w << 16); }
__device__ __forceinline__ float bf_hi(unsigned w) { return __uint_as_float(w & 0xffff0000u); }
__device__ __forceinline__ float bf2f(bf16_t b) { return __uint_as_float(((unsigned)b) << 16); }
__device__ __forceinline__ float rstd_of(float ss) { return rsqrtf(ss * (1.0f / DM) + EPS); }
__device__ __forceinline__ float sigmoidf_(float x) { return __builtin_amdgcn_rcpf(1.0f + __expf(-x)); }
__device__ __forceinline__ u32x4 pack8(const f32x4 a, const f32x4 b) { u32x4 w; w.x = cvt_pk_bf16(a[0], a[1]); w.y = cvt_pk_bf16(a[2], a[3]); w.z = cvt_pk_bf16(b[0], b[1]); w.w = cvt_pk_bf16(b[2], b[3]); return w; }
__device__ __forceinline__ void unpack8(const u32x4 w, f32x4& a, f32x4& b) { a[0] = bf_lo(w.x); a[1] = bf_hi(w.x); a[2] = bf_lo(w.y); a[3] = bf_hi(w.y); b[0] = bf_lo(w.z); b[1] = bf_hi(w.z); b[2] = bf_lo(w.w); b[3] = bf_hi(w.w); }

namespace pg8 {
constexpr int BM = 256, BK = 64, HALF = 128, HTB = HALF * BK * 2, STAGE_BYTES = 8 * HTB, NXCD = 8, WGM = 8;
__device__ __forceinline__ int lds_byte(int r, int c) { const int st = (r >> 4) * 2 + (c >> 5), rr = r & 15, cc = c & 31, ob = rr * 64 + cc * 2; return st * 1024 + (ob ^ (((ob >> 9) & 1) << 5)); }
__device__ __forceinline__ void stage_rc(int b, int& R, int& C) { const int st = b / 1024, sb = b % 1024, swz = sb ^ (((sb >> 9) & 1) << 5); R = (st >> 1) * 16 + swz / 64; C = (st & 1) * 32 + (swz % 64) / 2; }
__device__ __forceinline__ int perm32(int rho) { const int n = rho >> 4, i = rho & 15; return 8 * (i >> 2) + 4 * n + (i & 3); }

struct Unit { int pm, pn, aux, nt; const char* A; const char* B; };

__device__ __forceinline__ void remap(int L, int nM, int nN, int& pm, int& pn, const int WGM = 8) {
    const int nwg = nM * nN; int wgid = L;
    { const int q = nwg / NXCD, r = nwg % NXCD, xcd = wgid % NXCD, off = wgid / NXCD; wgid = (xcd < r ? xcd * (q + 1) : r * (q + 1) + (xcd - r) * q) + off; }
    const int nig = WGM * nN, gid = wgid / nig, fm = gid * WGM, gsz = (nM - fm) < WGM ? (nM - fm) : WGM;
    pm = fm + ((wgid % nig) % gsz); pn = (wgid % nig) / gsz;
}

template <class Epi, class Sched>
__device__ __forceinline__ void gemm_phase(LAS unsigned char* lds_in, const int lda, const int ldb, const Sched& S, const Epi& E, const int WID) {
    unsigned lds_u = (unsigned)(size_t)lds_in; asm volatile("" : "+s"(lds_u));
    LAS unsigned char* lds = (LAS unsigned char*)(size_t)lds_u;
    const int tid = opaque_tid(WID), wid = __builtin_amdgcn_readfirstlane(tid >> 6), lane = tid & 63, wr = wid >> 2, wc = wid & 3, fr = lane & 15, fq = lane >> 4;
    unsigned voffA[2], voffB[2];
#pragma unroll
    for (int i = 0; i < 2; ++i) { int R, C; stage_rc(tid * 16 + i * 8192, R, C); const int Rb = Epi::PERM ? ((R & ~31) + perm32(R & 31)) : R;
        voffA[i] = (unsigned)(R * lda + C) * 2u; voffB[i] = (unsigned)(Rb * ldb + C) * 2u; }
    const size_t kstep = (size_t)(BK * 2);
    const size_t hstepA = (size_t)HALF * lda * 2, hstepB = (size_t)HALF * ldb * 2;
    const unsigned ldsw = (unsigned)wid * 1024u;
    const int aoff = lds_byte(wr * 64 + fr, fq * 8), boff = lds_byte(wc * 32 + fr, fq * 8);
#define PG8_SA(b, h) (((b) * 2 + (h)) * HTB)
#define PG8_SB(b, h) ((4 + (b) * 2 + (h)) * HTB)
#define PG8_STAGE(bufoff, gbase, voff) do { _Pragma("unroll") for (int _i = 0; _i < 2; ++_i) \
        __builtin_amdgcn_global_load_lds((const unsigned*)((const char*)(gbase) + (voff)[_i]), (LAS unsigned*)(lds + (bufoff) + ldsw + _i * 8192), 16, 0, 0); } while (0)
#define PG8_LDA(dst, b, h) do { _Pragma("unroll") for (int m = 0; m < 4; ++m) _Pragma("unroll") for (int k = 0; k < 2; ++k) dst[m][k] = *(const LAS bf16x8*)(lds + PG8_SA(b, h) + aoff + m * 2048 + k * 1024); } while (0)
#define PG8_LDB(dst, b, h) do { _Pragma("unroll") for (int n = 0; n < 2; ++n) _Pragma("unroll") for (int k = 0; k < 2; ++k) dst[n][k] = *(const LAS bf16x8*)(lds + PG8_SB(b, h) + boff + n * 2048 + k * 1024); } while (0)
#define PG8_MMA(ai, bj, At, Bt) do { __builtin_amdgcn_s_setprio(1); _Pragma("unroll") for (int m = 0; m < 4; ++m) _Pragma("unroll") for (int n = 0; n < 2; ++n) _Pragma("unroll") for (int k = 0; k < 2; ++k) \
        acc[ai][bj][m][n] = __builtin_amdgcn_mfma_f32_16x16x32_bf16(Bt[n][k], At[m][k], acc[ai][bj][m][n], 0, 0, 0); __builtin_amdgcn_s_setprio(0); } while (0)
#define PG8_WAIT_V(n) asm volatile("s_waitcnt vmcnt(" #n ")" ::: "memory")
#define PG8_WAIT_L(n) asm volatile("s_waitcnt lgkmcnt(" #n ")" ::: "memory")
#define PG8_BAR __builtin_amdgcn_s_barrier()
#define PG8_SCHED __builtin_amdgcn_sched_barrier(0)
    Unit cur, nxt; int ui = 0;
    if (!S.next(0, cur)) return;
    f32x4 acc[2][2][4][2];
#pragma unroll
    for (int a = 0; a < 2; ++a)
#pragma unroll
        for (int b = 0; b < 2; ++b)
#pragma unroll
            for (int m = 0; m < 4; ++m)
#pragma unroll
                for (int n = 0; n < 2; ++n) acc[a][b][m][n] = (f32x4){0.f, 0.f, 0.f, 0.f};
    bf16x8 At[4][2], B0[2][2], B1[2][2];
    const char* cA = cur.A; const char* cB = cur.B;
    PG8_STAGE(PG8_SB(0, 0), cB, voffB); PG8_STAGE(PG8_SA(0, 0), cA, voffA); PG8_STAGE(PG8_SB(0, 1), cB + hstepB, voffB); PG8_STAGE(PG8_SA(0, 1), cA + hstepA, voffA);
    if (wr == 1) PG8_BAR;
    PG8_WAIT_V(4); PG8_BAR;
    PG8_STAGE(PG8_SB(1, 0), cB + kstep, voffB); PG8_STAGE(PG8_SA(1, 0), cA + kstep, voffA); PG8_STAGE(PG8_SB(1, 1), cB + hstepB + kstep, voffB);
    PG8_WAIT_V(6); PG8_BAR;
    for (;;) {
        const bool has_next = S.next(ui + 1, nxt);
        const char* nA = has_next ? nxt.A : cA; const char* nB = has_next ? nxt.B : cB;
        const int nt = cur.nt;
        for (int sg = 0; sg < (Epi::HAS_MID ? 3 : 1); ++sg) {
        const int tb = Epi::HAS_MID ? (sg == 0 ? 0 : (sg == 1 ? 16 : 24)) : 0, te = Epi::HAS_MID ? (sg == 0 ? 16 : (sg == 1 ? 24 : nt)) : nt;
        if constexpr (Epi::HAS_MID) { if (sg > 0) { PG8_SCHED; E.mid(acc, cur, tb, wr, wc, fr, fq); PG8_SCHED; } }
        for (int t = tb; t < te; t += 2) {
            const bool last = (t == nt - 2);
            const char* a1 = cA + (size_t)(t + 1) * kstep;
            const char* a2 = last ? nA : cA + (size_t)(t + 2) * kstep; const char* b2 = last ? nB : cB + (size_t)(t + 2) * kstep;
            const char* a3 = a2 + kstep; const char* b3 = b2 + kstep;
            PG8_LDB(B0, 0, 0); PG8_SCHED; PG8_LDA(At, 0, 0); PG8_STAGE(PG8_SA(1, 1), a1 + hstepA, voffA);
            PG8_WAIT_L(8); PG8_BAR; PG8_WAIT_L(0); PG8_MMA(0, 0, At, B0); PG8_BAR; PG8_SCHED;
            PG8_LDB(B1, 0, 1); PG8_STAGE(PG8_SB(0, 0), b2, voffB);
            PG8_BAR; PG8_WAIT_L(0); PG8_MMA(0, 1, At, B1); PG8_BAR;
            PG8_LDA(At, 0, 1); PG8_STAGE(PG8_SA(0, 0), a2, voffA);
            PG8_BAR; PG8_WAIT_L(0); PG8_MMA(1, 0, At, B0); PG8_BAR; PG8_SCHED;
            PG8_STAGE(PG8_SB(0, 1), b2 + hstepB, voffB);
            PG8_WAIT_V(6); PG8_BAR; PG8_MMA(1, 1, At, B1); PG8_BAR;
            PG8_LDB(B0, 1, 0); PG8_SCHED; PG8_LDA(At, 1, 0); PG8_STAGE(PG8_SA(0, 1), a2 + hstepA, voffA);
            PG8_WAIT_L(8); PG8_BAR; PG8_WAIT_L(0); PG8_MMA(0, 0, At, B0); PG8_BAR; PG8_SCHED;
            PG8_LDB(B1, 1, 1); PG8_STAGE(PG8_SB(1, 0), b3, voffB);
            PG8_BAR; PG8_WAIT_L(0); PG8_MMA(0, 1, At, B1); PG8_BAR;
            PG8_LDA(At, 1, 1); PG8_STAGE(PG8_SA(1, 0), a3, voffA);
            PG8_BAR; PG8_WAIT_L(0); PG8_MMA(1, 0, At, B0); PG8_BAR; PG8_SCHED;
            PG8_STAGE(PG8_SB(1, 1), b3 + hstepB, voffB);
            PG8_WAIT_V(6); PG8_BAR; PG8_MMA(1, 1, At, B1); PG8_BAR;
        }
        }
        E(acc, cur, wr, wc, fr, fq);
        if (!has_next) break;
#pragma unroll
        for (int a = 0; a < 2; ++a)
#pragma unroll
            for (int b = 0; b < 2; ++b)
#pragma unroll
                for (int m = 0; m < 4; ++m)
#pragma unroll
                    for (int n = 0; n < 2; ++n) acc[a][b][m][n] = (f32x4){0.f, 0.f, 0.f, 0.f};
        cur = nxt; cA = nA; cB = nB; ++ui;
    }
    PG8_WAIT_V(0);
    if (wr == 0) PG8_BAR;
    PG8_BAR;
#undef PG8_SA
#undef PG8_SB
#undef PG8_STAGE
#undef PG8_LDA
#undef PG8_LDB
#undef PG8_MMA
#undef PG8_WAIT_V
#undef PG8_WAIT_L
#undef PG8_BAR
#undef PG8_SCHED
}
}
using pg8::Unit;
typedef f32x4 AccT[2][2][4][2];

struct SchedB {
    const char* H; const char* W; int G, c;
    __device__ __forceinline__ bool next(int i, Unit& u) const {
        const int L = i * G + c; if (L >= 2688) return false; u.nt = 32;
        if (L < 2304) { pg8::remap(L, 64, 36, u.pm, u.pn); u.aux = 0; u.A = H + (size_t)u.pm * 256 * 2048 * 2; u.B = W + (size_t)(1536 + u.pn * 256) * 2048 * 2; }
        else { pg8::remap(L - 2304, 6, 64, u.pm, u.pn); u.aux = 1; u.A = W + (size_t)u.pm * 256 * 2048 * 2; u.B = H + (size_t)u.pn * 256 * 2048 * 2; }
        return true; }
};
struct SchedDFT {
    const char* Fm; const char* TT; int G, c;
    __device__ __forceinline__ bool next(int i, Unit& u) const {
        const int L = i * G + c; if (L >= 256) return false; int pmv, pn; pg8::remap(L, 128, 2, pmv, pn);
        const int pb = pmv >> 4; u.pm = pmv & 15; u.pn = pn; u.aux = pb; u.nt = 32;
        u.A = Fm + (size_t)u.pm * 256 * 2048 * 2; u.B = TT + ((size_t)pn * 256 * CH + (size_t)pb * 2048) * 2; return true; }
};
struct SchedMrg {
    const char* X; const char* W; int G, c;
    __device__ __forceinline__ bool next(int i, Unit& u) const {
        const int ti = i / 3, seg = i - ti * 3; const int L = ti * G + c; if (L >= 512) return false; pg8::remap(L, 64, 8, u.pm, u.pn);
        const int koff = seg == 0 ? 0 : (seg == 1 ? 1024 : 1536); u.nt = seg == 1 ? 8 : 16; u.aux = seg;
        u.A = X + ((size_t)u.pm * 256 * XW + koff) * 2; u.B = W + ((size_t)u.pn * 256 * XW + koff) * 2; return true; }
};
struct SchedPlain { const char* A; const char* B; int nM, nN, lda, ldb, nt, G, c, wgm;
    __device__ __forceinline__ bool next(int i, Unit& u) const {
        const int L = i * G + c; if (L >= nM * nN) return false; pg8::remap(L, nM, nN, u.pm, u.pn, wgm); u.aux = 0; u.nt = nt;
        u.A = A + (size_t)u.pm * 256 * lda * 2; u.B = B + (size_t)u.pn * 256 * ldb * 2; return true; }
};

struct EpiB { static constexpr bool PERM = true, HAS_MID = false; bf16_t* Z; bf16_t* TT; const float* bg; const float* SS; int sample;
    __device__ __forceinline__ void operator()(const AccT& acc, const Unit& u, int wr, int wc, int fr, int fq) const {
        const int row0 = u.pm * 256 + wr * 64 + fr, col0 = u.pn * 256 + wc * 32 + 8 * fq;
        if (u.aux == 0) {
            const bool gate = u.pn >= 12;
            float rsv[2][4]; f32x4 bb0[2], bb1[2];
#pragma unroll
            for (int ai = 0; ai < 2; ++ai)
#pragma unroll
                for (int m = 0; m < 4; ++m) rsv[ai][m] = SS[row0 + ai * 128 + m * 16];
#pragma unroll
            for (int bj = 0; bj < 2; ++bj) { bb0[bj] = (f32x4){0.f, 0.f, 0.f, 0.f}; bb1[bj] = bb0[bj];
                if (gate) { bb0[bj] = *(const f32x4*)(bg + col0 + bj * 128 - ZG); bb1[bj] = *(const f32x4*)(bg + col0 + bj * 128 - ZG + 4); } }
#pragma unroll
            for (int bj = 0; bj < 2; ++bj) {
                const f32x4 b0 = bb0[bj], b1 = bb1[bj];
#pragma unroll
                for (int ai = 0; ai < 2; ++ai)
#pragma unroll
                    for (int m = 0; m < 4; ++m) {
                        const float rs = rstd_of(rsv[ai][m]);
                        f32x4 v0 = acc[ai][bj][m][0] * rs, v1 = acc[ai][bj][m][1] * rs;
                        if (gate) {
#pragma unroll
                            for (int j = 0; j < 4; ++j) { v0[j] = sigmoidf_(v0[j] + b0[j]); v1[j] = sigmoidf_(v1[j] + b1[j]); } }
                        *(u32x4*)(Z + (size_t)(row0 + ai * 128 + m * 16) * ZW + col0 + bj * 128) = pack8(v0, v1);
                    }
            }
        } else {
            const bool scat = sample && u.pm < 2;
            f32x4 rs0[2], rs1[2];
#pragma unroll
            for (int bj = 0; bj < 2; ++bj) { const f32x4 a = *(const f32x4*)(SS + col0 + bj * 128), b = *(const f32x4*)(SS + col0 + bj * 128 + 4);
#pragma unroll
                for (int j = 0; j < 4; ++j) { rs0[bj][j] = rstd_of(a[j]); rs1[bj][j] = rstd_of(b[j]); } }
#pragma unroll
            for (int ai = 0; ai < 2; ++ai)
#pragma unroll
                for (int m = 0; m < 4; ++m) {
                    bf16_t* rp = TT + (size_t)(row0 + ai * 128 + m * 16) * CH;
#pragma unroll
                    for (int bj = 0; bj < 2; ++bj) {
                        const u32x4 w = pack8(acc[ai][bj][m][0] * rs0[bj], acc[ai][bj][m][1] * rs1[bj]);
                        const int tok = col0 + bj * 128;
                        if (!scat) *(u32x4*)(rp + tok) = w;
                        else {
                            const int b = tok >> 13, t = (tok & 8191) >> 2; bf16_t* q = rp + (b << 13) + t;
                            q[0] = (bf16_t)(w.x & 0xffff); q[2048] = (bf16_t)(w.x >> 16); q[4096] = (bf16_t)(w.y & 0xffff); q[6144] = (bf16_t)(w.y >> 16);
                            q[1] = (bf16_t)(w.z & 0xffff); q[2049] = (bf16_t)(w.z >> 16); q[4097] = (bf16_t)(w.w & 0xffff); q[6145] = (bf16_t)(w.w >> 16);
                        }
                    }
                }
        }
    }
};
struct EpiDFT { static constexpr bool PERM = true, HAS_MID = false; bf16_t* X; bf16_t* E; int sample;
    __device__ __forceinline__ void operator()(const AccT& acc, const Unit& u, int wr, int wc, int fr, int fq) const {
        const int part = u.pm >> 3, s0 = (u.pm & 7) * 256 + wr * 64 + fr, pb = u.aux;
#pragma unroll
        for (int bj = 0; bj < 2; ++bj) {
            const int dcol = (u.pn * 2 + bj) * 256 + part * 128 + wc * 32 + 8 * fq;
#pragma unroll
            for (int ai = 0; ai < 2; ++ai)
#pragma unroll
                for (int m = 0; m < 4; ++m) {
                    const size_t tok = (size_t)pb * 2048 + s0 + ai * 128 + m * 16;
                    bf16_t* dst = sample ? (E + tok * 1024 + dcol) : (X + tok * XW + dcol);
                    *(u32x4*)dst = pack8(acc[ai][bj][m][0], acc[ai][bj][m][1]);
                }
        }
    }
};
struct EpiMrg { static constexpr bool PERM = true, HAS_MID = false; const bf16_t* Z; bf16_t* M;
    __device__ __forceinline__ void operator()(const AccT& acc, const Unit& u, int wr, int wc, int fr, int fq) const {
        const int row0 = u.pm * 256 + wr * 64 + fr, col0 = u.pn * 256 + wc * 32 + 8 * fq, seg = u.aux;
#pragma unroll
        for (int ai = 0; ai < 2; ++ai)
#pragma unroll
            for (int m = 0; m < 4; ++m) {
                const size_t row = (size_t)(row0 + ai * 128 + m * 16);
#pragma unroll
                for (int bj = 0; bj < 2; ++bj) {
                    const u32x4 gw = *(const u32x4*)(Z + row * ZW + ZG + seg * 2048 + col0 + bj * 128);
                    f32x4 g0, g1; unpack8(gw, g0, g1);
                    f32x4 p0 = {0.f, 0.f, 0.f, 0.f}, p1 = p0;
                    bf16_t* mp = M + row * 2048 + col0 + bj * 128;
                    if (seg) { const u32x4 pw = *(const u32x4*)mp; unpack8(pw, p0, p1); }
                    *(u32x4*)mp = pack8(p0 + g0 * acc[ai][bj][m][0], p1 + g1 * acc[ai][bj][m][1]);
                }
                asm volatile("" ::: "memory");
            }
    }
};
struct EpiMrg2 { static constexpr bool PERM = true, HAS_MID = true; const bf16_t* Z; bf16_t* M;
    __device__ __forceinline__ void mid(AccT& acc, const Unit& u, int t, int wr, int wc, int fr, int fq) const {
        int row0 = u.pm * 256 + wr * 64 + fr, col0 = u.pn * 256 + wc * 32 + 8 * fq; const int seg = (t == 16) ? 0 : 1;
        asm volatile("" : "+v"(row0), "+v"(col0));
#pragma unroll
        for (int ai = 0; ai < 2; ++ai) {
            u32x4 ga[4][2], gb[4][2];
#pragma unroll
            for (int m = 0; m < 4; ++m)
#pragma unroll
                for (int bj = 0; bj < 2; ++bj) { const bf16_t* gp = Z + (size_t)(row0 + ai * 128 + m * 16) * ZW + ZG + seg * 2048 + col0 + bj * 128; ga[m][bj] = *(const u32x4*)gp; gb[m][bj] = *(const u32x4*)(gp + 2048); }
#pragma unroll
            for (int m = 0; m < 4; ++m)
#pragma unroll
                for (int bj = 0; bj < 2; ++bj) {
                    f32x4 a0, a1, b0, b1; unpack8(ga[m][bj], a0, a1); unpack8(gb[m][bj], b0, b1);
#pragma unroll
                    for (int j = 0; j < 4; ++j) { a0[j] = fmaxf(a0[j], 1e-20f) * __builtin_amdgcn_rcpf(fmaxf(b0[j], 1e-20f)); a1[j] = fmaxf(a1[j], 1e-20f) * __builtin_amdgcn_rcpf(fmaxf(b1[j], 1e-20f)); }
                    acc[ai][bj][m][0] *= a0; acc[ai][bj][m][1] *= a1;
                }
            asm volatile("" ::: "memory");
        }
    }
    __device__ __forceinline__ void operator()(const AccT& acc, const Unit& u, int wr, int wc, int fr, int fq) const {
        int row0 = u.pm * 256 + wr * 64 + fr, col0 = u.pn * 256 + wc * 32 + 8 * fq;
        asm volatile("" : "+v"(row0), "+v"(col0));
        u32x4 gw[2][4][2];
#pragma unroll
        for (int ai = 0; ai < 2; ++ai)
#pragma unroll
            for (int m = 0; m < 4; ++m)
#pragma unroll
                for (int bj = 0; bj < 2; ++bj) gw[ai][m][bj] = *(const u32x4*)(Z + (size_t)(row0 + ai * 128 + m * 16) * ZW + ZG + 2 * 2048 + col0 + bj * 128);
#pragma unroll
        for (int ai = 0; ai < 2; ++ai)
#pragma unroll
            for (int m = 0; m < 4; ++m) {
                const size_t row = (size_t)(row0 + ai * 128 + m * 16);
#pragma unroll
                for (int bj = 0; bj < 2; ++bj) {
                    f32x4 g0, g1; unpack8(gw[ai][m][bj], g0, g1);
#pragma unroll
                    for (int j = 0; j < 4; ++j) { g0[j] = fmaxf(g0[j], 1e-20f); g1[j] = fmaxf(g1[j], 1e-20f); }
                    *(u32x4*)(M + row * 2048 + col0 + bj * 128) = pack8(g0 * acc[ai][bj][m][0], g1 * acc[ai][bj][m][1]);
                }
            }
    }
};
struct EpiRes { static constexpr bool PERM = true, HAS_MID = false; bf16_t* Hb; float* outF; float* SS;
    __device__ __forceinline__ void operator()(const AccT& acc, const Unit& u, int wr, int wc, int fr, int fq) const {
        int row0 = u.pm * 256 + wr * 64 + fr, col0 = u.pn * 256 + wc * 32 + 8 * fq;
        asm volatile("" : "+v"(row0), "+v"(col0));
        u32x4 bw[2][4][2];
#pragma unroll
        for (int ai = 0; ai < 2; ++ai)
#pragma unroll
            for (int m = 0; m < 4; ++m)
#pragma unroll
                for (int bj = 0; bj < 2; ++bj) bw[ai][m][bj] = *(const u32x4*)(Hb + (size_t)(row0 + ai * 128 + m * 16) * 2048 + col0 + bj * 128);
#pragma unroll
        for (int ai = 0; ai < 2; ++ai) {
#pragma unroll
            for (int m = 0; m < 4; ++m) {
                const int row = row0 + ai * 128 + m * 16; const size_t off = (size_t)row * 2048 + col0; float ss = 0.f;
#pragma unroll
                for (int bj = 0; bj < 2; ++bj) {
                    f32x4 b0, b1; unpack8(bw[ai][m][bj], b0, b1);
                    const f32x4 o0 = b0 + acc[ai][bj][m][0], o1 = b1 + acc[ai][bj][m][1];
                    if (outF) { *(f32x4*)(outF + off + bj * 128) = o0; *(f32x4*)(outF + off + bj * 128 + 4) = o1; }
                    else { *(u32x4*)(Hb + off + bj * 128) = pack8(o0, o1);
                        ss += (o0[0] * o0[0] + o0[1] * o0[1]) + (o0[2] * o0[2] + o0[3] * o0[3]) + (o1[0] * o1[0] + o1[1] * o1[1]) + (o1[2] * o1[2] + o1[3] * o1[3]); }
                }
                if (!outF) { ss += __shfl_xor(ss, 16); ss += __shfl_xor(ss, 32); if (fq == 0) atomicAdd(SS + row, ss); }
            }
        }
    }
};
struct EpiRelu2 { static constexpr bool PERM = true, HAS_MID = false; bf16_t* Hd; const float* SS;
    __device__ __forceinline__ void operator()(const AccT& acc, const Unit& u, int wr, int wc, int fr, int fq) const {
        const int row0 = u.pm * 256 + wr * 64 + fr, col0 = u.pn * 256 + wc * 32 + 8 * fq;
        float rsv[2][4];
#pragma unroll
        for (int ai = 0; ai < 2; ++ai)
#pragma unroll
            for (int m = 0; m < 4; ++m) rsv[ai][m] = SS[row0 + ai * 128 + m * 16];
#pragma unroll
        for (int ai = 0; ai < 2; ++ai)
#pragma unroll
            for (int m = 0; m < 4; ++m) {
                const float rs = rstd_of(rsv[ai][m]);
#pragma unroll
                for (int bj = 0; bj < 2; ++bj) {
                    f32x4 v0 = acc[ai][bj][m][0] * rs, v1 = acc[ai][bj][m][1] * rs;
#pragma unroll
                    for (int j = 0; j < 4; ++j) { const float a = fmaxf(v0[j], 0.f), b = fmaxf(v1[j], 0.f); v0[j] = a * a; v1[j] = b * b; }
                    *(u32x4*)(Hd + (size_t)(row0 + ai * 128 + m * 16) * DFF + col0 + bj * 128) = pack8(v0, v1);
                }
            }
    }
};

struct TrTask { const float* src; size_t sld; bf16_t* dst; size_t dld; const float* gk; };
__device__ __forceinline__ int winT_row(int n0) {
    if (n0 < 512) return n0; if (n0 < 1024) return 1536 + (n0 - 512); if (n0 < 1536) return 2048 + (n0 - 1024);
    if (n0 < 2560) return 2560 + (n0 - 1536); if (n0 < 3584) return 3584 + (n0 - 2560); if (n0 < 4608) return 512 + (n0 - 3584); return n0;
}
__device__ __forceinline__ TrTask tr_decode(const Params& p, int t) {
    const int l = t / 30720; int r = t - l * 30720;
    unsigned char* wl = p.ws + OFF_W + (size_t)l * SZ_LAYER;
    bf16_t* WinT = (bf16_t*)wl; bf16_t* W1T = (bf16_t*)(wl + SZ_WIN); bf16_t* W2T = (bf16_t*)(wl + SZ_WIN + SZ_W1); bf16_t* WoT = (bf16_t*)(wl + SZ_WIN + SZ_W1 + SZ_W2); bf16_t* WcT = (bf16_t*)(wl + SZ_WIN + SZ_W1 + SZ_W2 + SZ_WO);
    if (r < 10752) { const int kt = r / 336, nt = r - kt * 336; return TrTask{p.in[3] + (size_t)l * 2048 * 10752 + (size_t)kt * 64 * 10752 + nt * 32, 10752, WinT + (size_t)winT_row(nt * 32) * 2048 + kt * 64, 2048, p.in[2] + l * DM + kt * 64}; }
    r -= 10752;
    if (r < 8192) { const int kt = r >> 8, nt = r & 255; return TrTask{p.in[17] + (size_t)l * 2048 * 8192 + (size_t)kt * 64 * 8192 + nt * 32, 8192, W1T + (size_t)nt * 32 * 2048 + kt * 64, 2048, p.in[16] + l * DM + kt * 64}; }
    r -= 8192;
    if (r < 8192) { const int kt = r >> 6, nt = r & 63; return TrTask{p.in[18] + (size_t)l * 8192 * 2048 + (size_t)kt * 64 * 2048 + nt * 32, 2048, W2T + (size_t)nt * 32 * 8192 + kt * 64, 8192, nullptr}; }
    r -= 8192;
    if (r < 2048) { const int kt = r >> 6, nt = r & 63; return TrTask{p.in[15] + (size_t)l * 2048 * 2048 + (size_t)kt * 64 * 2048 + nt * 32, 2048, WoT + (size_t)nt * 32 * 2048 + kt * 64, 2048, nullptr}; }
    r -= 2048;
    if (r < 512) { const int kt = r >> 6, nt = r & 63; return TrTask{p.in[10] + (size_t)l * 512 * 2048 + (size_t)kt * 64 * 2048 + nt * 32, 2048, WcT + (size_t)nt * 32 * XW + 1024 + kt * 64, XW, nullptr}; }
    r -= 512;
    { const int kt = r >> 6, nt = r & 63; return TrTask{p.in[14] + (size_t)l * 1024 * 2048 + (size_t)kt * 64 * 2048 + nt * 32, 2048, WcT + (size_t)nt * 32 * XW + 1536 + kt * 64, XW, nullptr}; }
}
__device__ void ph_prep(const Params& p, LAS unsigned char* lds_in, const int WID) {
    LAS unsigned char* lds = local_lds(lds_in);
    const int tid = opaque_tid(WID), lane = tid & 63, wv = __builtin_amdgcn_readfirstlane(tid >> 6);
    LAS float* tile = (LAS float*)lds + wv * (64 * 33);
    const int ri = lane >> 3, j4 = (lane & 7) * 4, k8 = (lane & 7) * 8;
    {
        int t = blockIdx.x * 8 + wv;
        TrTask cur = tr_decode(p, t);
        f32x4 v[8], gA, gB;
#pragma unroll
        for (int q = 0; q < 8; ++q) v[q] = *(const f32x4*)(cur.src + (size_t)(q * 8 + ri) * cur.sld + j4);
        { const float* gp = cur.gk ? cur.gk : p.in[2];
#pragma unroll
          for (int q = 0; q < 4; ++q) { gA[q] = gp[q * 8 + ri]; gB[q] = gp[(q + 4) * 8 + ri]; }
          if (!cur.gk) { gA = (f32x4){1.f, 1.f, 1.f, 1.f}; gB = gA; } }
        for (; t < 2 * 30720; t += NWAVES_TOTAL) {
            const int tn = t + NWAVES_TOTAL; const bool more = tn < 2 * 30720;
            const TrTask nxt = tr_decode(p, more ? tn : t);
            f32x4 vn[8], hA, hB;
#pragma unroll
            for (int q = 0; q < 8; ++q) vn[q] = *(const f32x4*)(nxt.src + (size_t)(q * 8 + ri) * nxt.sld + j4);
            { const float* gp = nxt.gk ? nxt.gk : p.in[2];
#pragma unroll
              for (int q = 0; q < 4; ++q) { hA[q] = gp[q * 8 + ri]; hB[q] = gp[(q + 4) * 8 + ri]; }
              if (!nxt.gk) { hA = (f32x4){1.f, 1.f, 1.f, 1.f}; hB = hA; } }
#pragma unroll
            for (int q = 0; q < 8; ++q) { const int i = q * 8 + ri; const f32x4 x = v[q] * (q < 4 ? gA[q & 3] : gB[q & 3]); tile[i * 33 + j4] = x[0]; tile[i * 33 + j4 + 1] = x[1]; tile[i * 33 + j4 + 2] = x[2]; tile[i * 33 + j4 + 3] = x[3]; }
            asm volatile("s_waitcnt lgkmcnt(0)" ::: "memory"); __builtin_amdgcn_wave_barrier();
#pragma unroll
            for (int q = 0; q < 4; ++q) { const int j = q * 8 + ri; f32x4 a, b;
#pragma unroll
                for (int e = 0; e < 4; ++e) { a[e] = tile[(k8 + e) * 33 + j]; b[e] = tile[(k8 + 4 + e) * 33 + j]; }
                *(u32x4*)(cur.dst + (size_t)j * cur.dld + k8) = pack8(a, b); }
            asm volatile("s_waitcnt lgkmcnt(0)" ::: "memory"); __builtin_amdgcn_wave_barrier();
            cur = nxt; gA = hA; gB = hB;
#pragma unroll
            for (int q = 0; q < 8; ++q) v[q] = vn[q];
        }
    }
    __syncthreads();
    LAS float* wt = (LAS float*)lds;
    LAS float* ctab = wt + 512 * 16;
    LAS float* stab = ctab + 128;
    if (tid < 128) { float sn, cs; sincospif((float)tid / 64.0f, &sn, &cs); ctab[tid] = cs; stab[tid] = sn; }
    for (int t = blockIdx.x; t < 2 * 128; t += gridDim.x) {
        const int l = t >> 7, e0 = (t & 127) * 16;
        __syncthreads();
        { const float* srow = p.in[5] + (size_t)l * 512 * 2048 + (size_t)tid * 2048 + e0;
#pragma unroll
          for (int q = 0; q < 4; ++q) *(LAS f32x4*)(wt + tid * 16 + q * 4) = *(const f32x4*)(srow + q * 4); }
        __syncthreads();
        bf16_t* WcT = (bf16_t*)(p.ws + OFF_W + (size_t)l * SZ_LAYER + SZ_WIN + SZ_W1 + SZ_W2 + SZ_WO);
#pragma unroll 1
        for (int q = 0; q < 2; ++q) {
            const int kp = tid + 512 * q, g = kp >> 8, part = (kp >> 7) & 1, c = kp & 127;
            f32x4 s0 = {0.f, 0.f, 0.f, 0.f}, s1 = s0, s2 = s0, s3 = s0;
            for (int m = 0; m < 128; ++m) {
                const int idx = (c * m) & 127; const float tw = part ? -stab[idx] : ctab[idx];
                const LAS float* wr_ = wt + (g * 128 + m) * 16;
                s0 += tw * *(const LAS f32x4*)wr_; s1 += tw * *(const LAS f32x4*)(wr_ + 4); s2 += tw * *(const LAS f32x4*)(wr_ + 8); s3 += tw * *(const LAS f32x4*)(wr_ + 12);
            }
            const float sc = 0.08838834764831845f;
#pragma unroll
            for (int e = 0; e < 4; ++e) {
                WcT[(size_t)(e0 + e) * XW + kp] = (bf16_t)(cvt_pk_bf16(s0[e] * sc, 0.f) & 0xffff);
                WcT[(size_t)(e0 + 4 + e) * XW + kp] = (bf16_t)(cvt_pk_bf16(s1[e] * sc, 0.f) & 0xffff);
                WcT[(size_t)(e0 + 8 + e) * XW + kp] = (bf16_t)(cvt_pk_bf16(s2[e] * sc, 0.f) & 0xffff);
                WcT[(size_t)(e0 + 12 + e) * XW + kp] = (bf16_t)(cvt_pk_bf16(s3[e] * sc, 0.f) & 0xffff);
            }
        }
    }
    bf16_t* Fm = (bf16_t*)(p.ws + OFF_FM);
    for (int it = blockIdx.x * NTHREADS + tid; it < 4096 * 256; it += gridDim.x * NTHREADS) {
        const int row = it >> 8, t0 = (it & 255) * 8, s = row & 2047, part = row >> 11;
        f32x4 a, b;
#pragma unroll
        for (int j = 0; j < 8; ++j) { float sn, cs; sincospif((float)((s * (t0 + j)) & 2047) / 1024.0f, &sn, &cs); const float v = (part ? sn : cs) * 0.022097086912079608f; if (j < 4) a[j] = v; else b[j - 4] = v; }
        *(u32x4*)(Fm + (size_t)row * 2048 + t0) = pack8(a, b);
    }
}

__device__ void ph_cvt(const float* __restrict__ x, bf16_t* __restrict__ H, float* __restrict__ SS, const int WID) {
    const int tid = opaque_tid(WID), lane = tid & 63, gw = blockIdx.x * 8 + __builtin_amdgcn_readfirstlane(tid >> 6);
    for (int row = gw * 2; row < CH; row += NWAVES_TOTAL * 2) {
        f32x4 v[2][8]; float ss[2] = {0.f, 0.f};
#pragma unroll
        for (int r = 0; r < 2; ++r)
#pragma unroll
            for (int i = 0; i < 8; ++i) v[r][i] = *(const f32x4*)(x + (size_t)(row + r) * DM + (i * 64 + lane) * 4);
#pragma unroll
        for (int r = 0; r < 2; ++r) {
#pragma unroll
            for (int i = 0; i < 8; ++i) ss[r] += v[r][i][0] * v[r][i][0] + v[r][i][1] * v[r][i][1] + v[r][i][2] * v[r][i][2] + v[r][i][3] * v[r][i][3];
#pragma unroll
            for (int o = 32; o >= 1; o >>= 1) ss[r] += __shfl_xor(ss[r], o);
#pragma unroll
            for (int i = 0; i < 8; ++i) { u32x2 w; w.x = cvt_pk_bf16(v[r][i][0], v[r][i][1]); w.y = cvt_pk_bf16(v[r][i][2], v[r][i][3]); *(u32x2*)(H + (size_t)(row + r) * DM + (i * 64 + lane) * 4) = w; }
            if (lane == 0) SS[row + r] = ss[r];
        }
    }
}
__device__ __forceinline__ void zero_rows(float* SS, const int WID) { for (int i = blockIdx.x * NTHREADS + opaque_tid(WID); i < CH; i += NBLOCKS * NTHREADS) SS[i] = 0.f; }

__device__ void ph_conv(const bf16_t* Z, bf16_t* X, const float* dw, const float* db, const float* lng, const float* lnb, int S, LAS unsigned char* lds_in, const int WID) {
    LAS unsigned char* lds = local_lds(lds_in);
    LAS bf16_t* ut = (LAS bf16_t*)lds;
    LAS float* yt = (LAS float*)(lds + 65536);
    const int tid = opaque_tid(WID), lane = tid & 63, wid = __builtin_amdgcn_readfirstlane(tid >> 6);
    float w[31];
#pragma unroll
    for (int j = 0; j < 31; ++j) w[j] = dw[j * 512 + tid];
    const float bias = db[tid];
    const f32x4 lg0 = *(const f32x4*)(lng + lane * 8), lg1 = *(const f32x4*)(lng + lane * 8 + 4), lb0 = *(const f32x4*)(lnb + lane * 8), lb1 = *(const f32x4*)(lnb + lane * 8 + 4);
    for (int tl = blockIdx.x; tl < CH / 32; tl += gridDim.x) {
        const int t0 = tl * 32, ss0 = (t0 / S) * S, se = ss0 + S;
        __syncthreads();
        {
            u32x4 aw[8], gw[8];
#pragma unroll
            for (int k = 0; k < 8; ++k) {
                const int idx = min(tid + k * NTHREADS, 62 * 64 - 1), rr = idx >> 6, c8 = (idx & 63) * 8, tok = min(max(t0 - 15 + rr, ss0), se - 1);
                aw[k] = *(const u32x4*)(Z + (size_t)tok * ZW + c8); gw[k] = *(const u32x4*)(Z + (size_t)tok * ZW + 512 + c8);
            }
#pragma unroll
            for (int k = 0; k < 8; ++k) {
                const int idx = tid + k * NTHREADS, rr = idx >> 6, c8 = (idx & 63) * 8, tok = t0 - 15 + rr;
                const float keep = (tok >= ss0 && tok < se) ? 1.0f : 0.0f;
                f32x4 a0, a1, g0, g1; unpack8(aw[k], a0, a1); unpack8(gw[k], g0, g1);
#pragma unroll
                for (int j = 0; j < 4; ++j) { a0[j] *= sigmoidf_(g0[j]) * keep; a1[j] *= sigmoidf_(g1[j]) * keep; }
                if (idx < 62 * 64) *(LAS u32x4*)(ut + rr * 512 + c8) = pack8(a0, a1);
            }
        }
        __syncthreads();
        for (int tt = 0; tt < 32; tt += 4) {
            float a0 = bias, a1 = bias, a2 = bias, a3 = bias;
#pragma unroll
            for (int jj = 0; jj < 34; ++jj) {
                const float xv = bf2f(ut[(tt + jj) * 512 + tid]);
                if (jj < 31) a0 += w[jj < 31 ? jj : 0] * xv;
                if (jj >= 1 && jj < 32) a1 += w[(jj >= 1 && jj < 32) ? jj - 1 : 0] * xv;
                if (jj >= 2 && jj < 33) a2 += w[(jj >= 2 && jj < 33) ? jj - 2 : 0] * xv;
                if (jj >= 3) a3 += w[jj >= 3 ? jj - 3 : 0] * xv;
            }
            yt[tt * 512 + tid] = a0; yt[(tt + 1) * 512 + tid] = a1; yt[(tt + 2) * 512 + tid] = a2; yt[(tt + 3) * 512 + tid] = a3;
        }
        __syncthreads();
#pragma unroll
        for (int q = 0; q < 4; ++q) {
            const int tt = wid * 4 + q;
            const f32x4 y0 = *(const LAS f32x4*)(yt + tt * 512 + lane * 8), y1 = *(const LAS f32x4*)(yt + tt * 512 + lane * 8 + 4);
            float s = (y0[0] + y0[1]) + (y0[2] + y0[3]) + (y1[0] + y1[1]) + (y1[2] + y1[3]);
#pragma unroll
            for (int o = 32; o >= 1; o >>= 1) s += __shfl_xor(s, o);
            const float mu = s * (1.0f / 512.0f);
            const f32x4 d0 = y0 - mu, d1 = y1 - mu;
            float qv = (d0[0] * d0[0] + d0[1] * d0[1]) + (d0[2] * d0[2] + d0[3] * d0[3]) + (d1[0] * d1[0] + d1[1] * d1[1]) + (d1[2] * d1[2] + d1[3] * d1[3]);
#pragma unroll
            for (int o = 32; o >= 1; o >>= 1) qv += __shfl_xor(qv, o);
            const float rstd = rsqrtf(qv * (1.0f / 512.0f) + EPS);
            f32x4 v0 = d0 * rstd * lg0 + lb0, v1 = d1 * rstd * lg1 + lb1;
#pragma unroll
            for (int j = 0; j < 4; ++j) { v0[j] *= sigmoidf_(v0[j]); v1[j] *= sigmoidf_(v1[j]); }
            *(u32x4*)(X + (size_t)(t0 + tt) * XW + 1024 + lane * 8) = pack8(v0, v1);
        }
    }
    __syncthreads();
}

__device__ void ph_qknorm(bf16_t* Z, const float* qg, const float* kg, const int WID) {
    const int tid = opaque_tid(WID), lane = tid & 63, gw = blockIdx.x * 8 + __builtin_amdgcn_readfirstlane(tid >> 6);
    f32x4 qgv[4], kgv[4];
#pragma unroll
    for (int e = 0; e < 4; ++e) { qgv[e] = *(const f32x4*)(qg + (lane & 7) * 16 + e * 4); kgv[e] = *(const f32x4*)(kg + (lane & 7) * 16 + e * 4); }
    for (int it0 = gw * 4; it0 < 2 * CH; it0 += NWAVES_TOTAL * 4) {
        u32x4 w0[4], w1[4];
#pragma unroll
        for (int q = 0; q < 4; ++q) { const int item = it0 + q; const bf16_t* ptr = Z + (size_t)(item >> 1) * ZW + ZQ + (item & 1) * 1024 + lane * 16; w0[q] = *(const u32x4*)ptr; w1[q] = *(const u32x4*)(ptr + 8); }
#pragma unroll
        for (int q = 0; q < 4; ++q) {
            const int item = it0 + q, isk = item & 1;
            bf16_t* ptr = Z + (size_t)(item >> 1) * ZW + ZQ + isk * 1024 + lane * 16;
            f32x4 a0, a1, a2, a3; unpack8(w0[q], a0, a1); unpack8(w1[q], a2, a3);
            float ss = 0.f;
#pragma unroll
            for (int j = 0; j < 4; ++j) ss += a0[j] * a0[j] + a1[j] * a1[j] + a2[j] * a2[j] + a3[j] * a3[j];
            ss += __shfl_xor(ss, 1); ss += __shfl_xor(ss, 2); ss += __shfl_xor(ss, 4);
            const float rstd = rsqrtf(ss * (1.0f / 128.0f) + EPS) * (isk ? 1.0f : 0.08838834764831845f);
            const f32x4 g0 = isk ? kgv[0] : qgv[0], g1 = isk ? kgv[1] : qgv[1], g2 = isk ? kgv[2] : qgv[2], g3 = isk ? kgv[3] : qgv[3];
            *(u32x4*)ptr = pack8(a0 * rstd * g0, a1 * rstd * g1); *(u32x4*)(ptr + 8) = pack8(a2 * rstd * g2, a3 * rstd * g3);
        }
    }
}

template <int SHIFT>
__device__ __forceinline__ void attn_pair(const bf16_t* Z, const bf16_t* TT, bf16_t* X, const LAS float* rp, int S, int b, int h, int r0, int rsA, int j, int lane, float kbound, float bmax, LAS u32x4* pl) {
    constexpr int NR = 8 + SHIFT;
    const int g = lane >> 4, n = lane & 15;
    const int kk0 = (n >> 2) * 8 + (n & 3);
    const int c0 = (j == 0) ? 0 : (j == 1) ? 8 : (j == 2) ? 24 : 32;
    const int tokq = b * S + r0 * 64 + j * 16 + n;
    const int tok0 = b * S + rsA * 64 + c0;
    const char* qU = (const char*)Z + ((size_t)(b * S + r0 * 64 + j * 16) * ZW + ZQ + h * 128) * 2; const unsigned qL = (unsigned)(n * ZW + g * 8) * 2u;
    const char* kU = (const char*)Z + ((size_t)tok0 * ZW + ZK + h * 128) * 2; const unsigned kL = (unsigned)(kk0 * ZW + g * 8) * 2u;
    const char* vU = (const char*)TT + ((size_t)(512 + h * 128) * CH + tok0) * 2; const unsigned vL = (unsigned)(n * CH + g * 8) * 2u;
    bf16x8 qA[4], qB[4];
#pragma unroll
    for (int ks = 0; ks < 4; ++ks) { qA[ks] = *(const bf16x8*)(qU + ks * 64 + qL); qB[ks] = *(const bf16x8*)(qU + (size_t)64 * ZW * 2 + ks * 64 + qL); }
    bf16x8 kf[2][8];
#define ATT_LOADK(buf, i) do { const char* _k = kU + (size_t)(i) * 64 * ZW * 2; _Pragma("unroll") for (int ks = 0; ks < 4; ++ks) { kf[buf][ks] = *(const bf16x8*)(_k + ks * 64 + kL); kf[buf][4 + ks] = *(const bf16x8*)(_k + (size_t)4 * ZW * 2 + ks * 64 + kL); } } while (0)
    ATT_LOADK(0, 0); ATT_LOADK(1, 1);
    float ssA = 0.f, ssB = 0.f;
#pragma unroll
    for (int ks = 0; ks < 4; ++ks) { u32x4 wa, wb; __builtin_memcpy(&wa, &qA[ks], 16); __builtin_memcpy(&wb, &qB[ks], 16); f32x4 a0, a1, b0, b1; unpack8(wa, a0, a1); unpack8(wb, b0, b1);
#pragma unroll
        for (int e = 0; e < 4; ++e) { ssA += a0[e] * a0[e] + a1[e] * a1[e]; ssB += b0[e] * b0[e] + b1[e] * b1[e]; } }
    ssA += __shfl_xor(ssA, 16); ssA += __shfl_xor(ssA, 32); ssB += __shfl_xor(ssB, 16); ssB += __shfl_xor(ssB, 32);
    const float CA = sqrtf(ssA) * kbound + bmax, CB = sqrtf(ssB) * kbound + bmax;
    const int c = j * 16 + n, start = min(max(c - 8, 0), 48);
    float lA = 0.f, lB = 0.f;
#define ATT_SCORE(QF, CC, DR, PDST, LSUM) do { \
        f32x4 s0 = {0.f, 0.f, 0.f, 0.f}, s1 = s0; \
        _Pragma("unroll") for (int ks = 0; ks < 4; ++ks) { s0 = __builtin_amdgcn_mfma_f32_16x16x32_bf16(kf[i % 2][ks], QF[ks], s0, 0, 0, 0); s1 = __builtin_amdgcn_mfma_f32_16x16x32_bf16(kf[i % 2][4 + ks], QF[ks], s1, 0, 0, 0); } \
        const LAS float* bp = rp + (h * 15 + (DR)) * 31; \
        _Pragma("unroll") for (int jj = 0; jj < 4; ++jj) { \
            const int kc0 = c0 + g * 8 + jj, kc1 = kc0 + 4; \
            const bool v0 = (kc0 >= start) && (kc0 < start + 16), v1 = (kc1 >= start) && (kc1 < start + 16); \
            const float p0 = v0 ? __expf(s0[jj] + bp[min(max(kc0 - c + 15, 0), 30)] - (CC)) : 0.f; \
            const float p1 = v1 ? __expf(s1[jj] + bp[min(max(kc1 - c + 15, 0), 30)] - (CC)) : 0.f; \
            s0[jj] = p0; s1[jj] = p1; LSUM += p0 + p1; } \
        pl[(PDST) * 64] = pack8(s0, s1); } while (0)
#pragma unroll
    for (int i = 0; i < NR; ++i) {
        if (i < 8) ATT_SCORE(qA, CA, (rsA + i) - r0 + 7, i, lA);
        __builtin_amdgcn_sched_barrier(0);
        if (i >= SHIFT && i - SHIFT < 8) ATT_SCORE(qB, CB, (rsA + i) - (r0 + 1) + 7, 8 + i - SHIFT, lB);
        __builtin_amdgcn_sched_barrier(0);
        if (i + 2 < NR) ATT_LOADK(i % 2, i + 2);
        asm volatile("" ::: "memory"); __builtin_amdgcn_sched_barrier(0);
    }
#undef ATT_SCORE
#undef ATT_LOADK
    bf16x8 vf[2][8];
#define ATT_LOADV(buf, i) do { const char* _v = vU + (i) * 128; _Pragma("unroll") for (int dt = 0; dt < 8; ++dt) vf[buf][dt] = *(const bf16x8*)(_v + (size_t)dt * 16 * CH * 2 + vL); } while (0)
    ATT_LOADV(0, 0); ATT_LOADV(1, 1);
    lA += __shfl_xor(lA, 16); lA += __shfl_xor(lA, 32); lB += __shfl_xor(lB, 16); lB += __shfl_xor(lB, 32);
    const float invA = 1.0f / lA, invB = 1.0f / lB;
    f32x4 oA[8], oB[8];
#pragma unroll
    for (int dt = 0; dt < 8; ++dt) { oA[dt] = (f32x4){0.f, 0.f, 0.f, 0.f}; oB[dt] = (f32x4){0.f, 0.f, 0.f, 0.f}; }
#pragma unroll
    for (int i = 0; i < NR; ++i) {
        if (i < 8) { const u32x4 pw = pl[i * 64]; bf16x8 pb; __builtin_memcpy(&pb, &pw, 16);
#pragma unroll
            for (int dt = 0; dt < 8; ++dt) oA[dt] = __builtin_amdgcn_mfma_f32_16x16x32_bf16(vf[i % 2][dt], pb, oA[dt], 0, 0, 0); }
        if (i >= SHIFT && i - SHIFT < 8) { const u32x4 pw = pl[(8 + i - SHIFT) * 64]; bf16x8 pb; __builtin_memcpy(&pb, &pw, 16);
#pragma unroll
            for (int dt = 0; dt < 8; ++dt) oB[dt] = __builtin_amdgcn_mfma_f32_16x16x32_bf16(vf[i % 2][dt], pb, oB[dt], 0, 0, 0); }
        __builtin_amdgcn_sched_barrier(0);
        if (i + 2 < NR) ATT_LOADV(i % 2, i + 2);
        asm volatile("" ::: "memory"); __builtin_amdgcn_sched_barrier(0);
    }
#undef ATT_LOADV
    bf16_t* op = X + (size_t)tokq * XW + 1536 + h * 128 + g * 4;
#pragma unroll
    for (int dt = 0; dt < 8; ++dt) {
        u32x2 w; w.x = cvt_pk_bf16(oA[dt][0] * invA, oA[dt][1] * invA); w.y = cvt_pk_bf16(oA[dt][2] * invA, oA[dt][3] * invA); *(u32x2*)(op + dt * 16) = w;
        u32x2 v; v.x = cvt_pk_bf16(oB[dt][0] * invB, oB[dt][1] * invB); v.y = cvt_pk_bf16(oB[dt][2] * invB, oB[dt][3] * invB); *(u32x2*)(op + (size_t)64 * XW + dt * 16) = v;
    }
}
__device__ void ph_attn(const bf16_t* Z, const bf16_t* TT, bf16_t* X, const float* rpb, const float* kg, int S, int rows, int nb, LAS unsigned char* lds_in, const int WID) {
    LAS unsigned char* lds = local_lds(lds_in);
    const int tid = opaque_tid(WID), lane = tid & 63;
    LAS float* rp = (LAS float*)lds;
    __syncthreads();
    for (int i = tid; i < 8 * 15 * 31; i += NTHREADS) rp[i] = rpb[i];
    __syncthreads();
    float bmax = 0.f;
    for (int i = lane; i < 8 * 15 * 31; i += 64) bmax = fmaxf(bmax, fabsf(rp[i]));
    float gmax = fmaxf(fabsf(kg[lane]), fabsf(kg[lane + 64]));
#pragma unroll
    for (int o = 32; o >= 1; o >>= 1) { bmax = fmaxf(bmax, __shfl_xor(bmax, o)); gmax = fmaxf(gmax, __shfl_xor(gmax, o)); }
    const float kbound = gmax * 11.313708499f * 1.01f;
    const int vblk = (blockIdx.x & 7) * (NBLOCKS / 8) + (blockIdx.x >> 3);
    const int gw = vblk * 8 + __builtin_amdgcn_readfirstlane(tid >> 6);
    LAS u32x4* pl = (LAS u32x4*)(lds + 15360) + __builtin_amdgcn_readfirstlane(tid >> 6) * (16 * 64) + lane;
    const int hrows = rows >> 1, total = nb * 8 * hrows * 4;
    for (int u = gw; u < total; u += NWAVES_TOTAL) {
        const int j = u & 3, rr = u >> 2, rpi = rr % hrows, bh = rr / hrows, h = bh & 7, b = bh >> 3;
        const int r0 = 2 * rpi, rsA = min(max(r0 - 4, 0), rows - 8), rsB = min(max(r0 - 3, 0), rows - 8);
        if (rsB != rsA) attn_pair<1>(Z, TT, X, rp, S, b, h, r0, rsA, j, lane, kbound, bmax, pl);
        else attn_pair<0>(Z, TT, X, rp, S, b, h, r0, rsA, j, lane, kbound, bmax, pl);
    }
}

__device__ void ph_combine(const bf16_t* E, bf16_t* X, const int WID) {
    const int tid = opaque_tid(WID), lane = tid & 63, gw = blockIdx.x * 8 + __builtin_amdgcn_readfirstlane(tid >> 6);
    const int gq = lane >> 4, c8 = (lane & 15) * 8;
    for (int item = gw; item < CH; item += NWAVES_TOTAL) {
        const int b = item >> 13, k = item & 8191, m = k & 2047;
        f32x4 xc0 = {0.f, 0.f, 0.f, 0.f}, xc1 = xc0, xs0 = xc0, xs1 = xc0;
#pragma unroll
        for (int r = 0; r < 4; ++r) {
            float sn, cs; sincospif((float)((r * k) & 8191) / 4096.0f, &sn, &cs);
            const bf16_t* ep = E + (size_t)((b * 4 + r) * 2048 + m) * 1024 + gq * 256 + c8;
            const u32x4 cw = *(const u32x4*)ep, sw = *(const u32x4*)(ep + 128);
            f32x4 ec0, ec1, es0, es1; unpack8(cw, ec0, ec1); unpack8(sw, es0, es1);
            xc0 += cs * ec0 - sn * es0; xc1 += cs * ec1 - sn * es1;
            xs0 += cs * es0 + sn * ec0; xs1 += cs * es1 + sn * ec1;
        }
        bf16_t* xp = X + (size_t)item * XW + gq * 256 + c8;
        *(u32x4*)xp = pack8(xc0 * 0.5f, xc1 * 0.5f); *(u32x4*)(xp + 128) = pack8(xs0 * 0.5f, xs1 * 0.5f);
    }
}


#define XB_TMO      128
#define XB_XCNT(j)  (256  + 64 * (j))
#define XB_XSUB(j)  (1280 + 64 * (j))
#define XB_XGEN(j)  (2304 + 64 * (j))
#define XB_TOP      3328
#define XB_TOPGEN   3392
#define XCD_BAR_WORDS 3456
#define XB_SPIN_CAP (1u << 20)
__device__ __forceinline__ unsigned xb_ld(unsigned* p)              { return __hip_atomic_load(p, __ATOMIC_RELAXED, __HIP_MEMORY_SCOPE_AGENT); }
__device__ __forceinline__ unsigned xb_add(unsigned* p, unsigned v) { return __hip_atomic_fetch_add(p, v, __ATOMIC_RELAXED, __HIP_MEMORY_SCOPE_AGENT); }
__device__ __forceinline__ unsigned xb_xcc_id() { return (unsigned)__builtin_amdgcn_s_getreg((3 << 11) | 20) & 0xFu; }
#define XB_SPIN(cond, bar) do { unsigned _sp = 0; while (cond) { __builtin_amdgcn_s_sleep(1); \
    if ((++_sp & 255u) == 0u) { if (xb_ld(&(bar)[XB_TMO])) break; if (_sp > XB_SPIN_CAP) { atomicAdd(&(bar)[XB_TMO], 1u); break; } } } } while (0)
struct XcdBarrier { unsigned* bar; unsigned x; volatile LAS unsigned* st; };
__device__ __forceinline__ XcdBarrier xcd_barrier_post(unsigned* bar, volatile LAS unsigned* st) {
    XcdBarrier b; b.bar = bar; b.x = xb_xcc_id(); b.st = st;
    if (threadIdx.x == 0) (void)xb_add(&bar[XB_XCNT(b.x)], 1u);
    return b;
}
__device__ __forceinline__ void xcd_barrier_complete(unsigned* bar, unsigned x, unsigned& nloc, unsigned& nx) {
    const unsigned G = gridDim.x * gridDim.y * gridDim.z;
    unsigned sum, cnt, mine, sp = 0u;
    for (;;) {
        sum = 0u; cnt = 0u; mine = 0u;
#pragma unroll
        for (unsigned j = 0; j < 16; ++j) { const unsigned c = xb_ld(&bar[XB_XCNT(j)]); sum += c; cnt += (c > 0u) ? 1u : 0u; }
        mine = xb_ld(&bar[XB_XCNT(x)]);
        if (sum == G) break;
        __builtin_amdgcn_s_sleep(1);
        if ((++sp & 255u) == 0u) { if (xb_ld(&bar[XB_TMO])) break; if (sp > XB_SPIN_CAP) { atomicAdd(&bar[XB_TMO], 1u); break; } }
    }
    nloc = mine > 0u ? mine : 1u; nx = cnt > 0u ? cnt : 1u;
}
__device__ __forceinline__ void xcd_barrier(const XcdBarrier& b, const int WID) {
    asm volatile("s_waitcnt vmcnt(0)" ::: "memory");
    __syncthreads();
    if (opaque_tid(WID) == 0) {
        unsigned* bar = b.bar; asm volatile("" : "+s"(bar));
        __builtin_amdgcn_s_waitcnt(0);
        unsigned nloc = b.st[0], nx = b.st[1];
        if (nloc == 0u) { xcd_barrier_complete(bar, b.x, nloc, nx); b.st[0] = nloc; b.st[1] = nx; }
        const unsigned old = xb_add(&bar[XB_XSUB(b.x)], 1u);
        const unsigned gen = old / nloc;
        if (old + 1u == (gen + 1u) * nloc) {
            __builtin_amdgcn_fence(__ATOMIC_RELEASE, "agent");
            asm volatile("s_waitcnt vmcnt(0)" ::: "memory");
            const unsigned og = xb_add(&bar[XB_TOP], 1u);
            const unsigned tg = og / nx;
            if (og + 1u == (tg + 1u) * nx) xb_add(&bar[XB_TOPGEN], 1u);
            else XB_SPIN(xb_ld(&bar[XB_TOPGEN]) == tg, bar);
            __builtin_amdgcn_fence(__ATOMIC_ACQUIRE, "agent");
            xb_add(&bar[XB_XGEN(b.x)], 1u);
            asm volatile("s_waitcnt vmcnt(0)" ::: "memory");
        } else {
            XB_SPIN(xb_ld(&bar[XB_XGEN(b.x)]) == gen, bar);
            __builtin_amdgcn_fence(__ATOMIC_ACQUIRE, "agent");
            asm volatile("s_waitcnt vmcnt(0)" ::: "memory");
        }
    }
    __syncthreads();
}

constexpr int STEPS = 15;
constexpr int N_PHASES = 1 + NCHUNK * STEPS;

__global__ void __launch_bounds__(NTHREADS, 2) fwd_kernel(Params p) {
    extern __shared__ __attribute__((aligned(16))) unsigned char lds_raw[];
    LAS unsigned char* lds = (LAS unsigned char*)lds_raw;
    const int G = gridDim.x, cblk = blockIdx.x;
    const int WID = __builtin_amdgcn_readfirstlane((int)threadIdx.x >> 6);
    if (threadIdx.x < 4) ((LAS unsigned*)(lds + LDS_BAR_OFF))[threadIdx.x] = 0u;
    __syncthreads();
    const XcdBarrier xbar = xcd_barrier_post((unsigned*)(p.ws + OFF_BAR), (volatile LAS unsigned*)(lds + LDS_BAR_OFF));
    unsigned char* ws = p.ws;
    bf16_t* Fm = (bf16_t*)(ws + OFF_FM); bf16_t* H = (bf16_t*)(ws + OFF_H); bf16_t* Z = (bf16_t*)(ws + OFF_Z); bf16_t* HID = Z;
    bf16_t* TT = (bf16_t*)(ws + OFF_TT); bf16_t* E = (bf16_t*)(ws + OFF_E); bf16_t* X = (bf16_t*)(ws + OFF_X); bf16_t* M = (bf16_t*)(ws + OFF_M);
    ph_prep(p, lds, WID);
    asm volatile("" ::: "memory");
    cg::this_grid().sync();
    for (int phi = 1; phi < N_PHASES; ++phi) {
        int ph = phi, cb = cblk, Gv = G; asm volatile("" : "+s"(ph), "+s"(cb), "+s"(Gv));
        {
            const int q = ph - 1, chunk = q / STEPS, step = q % STEPS, layer = step >= 8 ? 1 : 0, sub = step == 0 ? 0 : (step - 1) % 7 + 1;
            const int sample = chunk == 2, S = sample ? 8192 : 2048, rows = S / 64, nb = CH / S;
            const unsigned char* wl = ws + OFF_W + (size_t)layer * SZ_LAYER;
            const char* WinT = (const char*)wl; const char* W1T = (const char*)(wl + SZ_WIN); const char* W2T = (const char*)(wl + SZ_WIN + SZ_W1);
            const char* WoT = (const char*)(wl + SZ_WIN + SZ_W1 + SZ_W2); const char* WcT = (const char*)(wl + SZ_WIN + SZ_W1 + SZ_W2 + SZ_WO);
            float* xout = p.out + (size_t)chunk * CH * DM;
            const float* xin = layer == 0 ? (sample ? p.in[1] : p.in[0] + (size_t)chunk * CH * DM) : xout;
            float* SS1 = (float*)(ws + OFF_SS1); float* SS2 = (float*)(ws + OFF_SS2);
            switch (sub) {
            case 0: ph_cvt(xin, H, SS1, WID); break;
            case 1: { zero_rows(SS2, WID); SchedB Sc{(const char*)H, WinT, Gv, cb}; EpiB Ep{Z, TT, p.in[4] + layer * 6144, SS1, sample}; pg8::gemm_phase(lds, 2048, 2048, Sc, Ep, WID); } break;
            case 2: { SchedDFT Sc{(const char*)Fm, (const char*)TT, Gv, cb}; EpiDFT Ep{X, E, sample}; pg8::gemm_phase(lds, 2048, CH, Sc, Ep, WID);
                      __syncthreads();
                      ph_conv(Z, X, p.in[6] + layer * 31 * 512, p.in[7] + layer * 512, p.in[8] + layer * 512, p.in[9] + layer * 512, S, lds, WID);
                      ph_qknorm(Z, p.in[11] + layer * 128, p.in[12] + layer * 128, WID); } break;
            case 3: { int reps = (PROBE_DUP == 3) ? 2 : 1; asm volatile("" : "+s"(reps)); for (int rep = 0; rep < reps; ++rep) { ph_attn(Z, TT, X, p.in[13] + layer * 8 * 15 * 31, p.in[12] + layer * 128, S, rows, nb, lds, WID); if (sample) ph_combine(E, X, WID); asm volatile("" ::: "memory"); } } break;
            case 4: { SchedPlain Sc{(const char*)X, WcT, 64, 8, XW, XW, 40, Gv, cb, 4}; EpiMrg2 Ep{Z, M}; pg8::gemm_phase(lds, XW, XW, Sc, Ep, WID); } break;
            case 5: { zero_rows(SS1, WID); SchedPlain Sc{(const char*)M, WoT, 64, 8, 2048, 2048, 32, Gv, cb, 4}; EpiRes Ep{H, (float*)nullptr, SS2}; pg8::gemm_phase(lds, 2048, 2048, Sc, Ep, WID); } break;
            case 6: { SchedPlain Sc{(const char*)H, W1T, 64, 32, 2048, 2048, 32, Gv, cb, 8}; EpiRelu2 Ep{HID, SS2}; pg8::gemm_phase(lds, 2048, 2048, Sc, Ep, WID); } break;
            case 7: { SchedPlain Sc{(const char*)HID, W2T, 64, 8, 8192, 8192, 128, Gv, cb, 4}; EpiRes Ep{H, layer == 0 ? (float*)nullptr : xout, SS1}; pg8::gemm_phase(lds, 8192, 8192, Sc, Ep, WID); } break;
            }
        }
        asm volatile("" ::: "memory");
        if (phi + 1 < N_PHASES) { xcd_barrier(xbar, WID); for (int e = 0; e < PROBE_SYNCS; ++e) xcd_barrier(xbar, WID); }
    }
}

extern "C" void kernel_launch(void* const* d_in, const int* in_sizes, int n_in, void* d_out, int out_size, void* d_ws, size_t ws_size, hipStream_t stream) {
    static int ready = 0;
    if (!ready) {
        if (n_in != 19 || ws_size < WS_END) { fprintf(stderr, "kernel_launch: unexpected n_in %d / ws_size %zu (need %zu)\n", n_in, ws_size, (size_t)WS_END); ready = -1; return; }
        if (hipFuncSetAttribute((const void*)fwd_kernel, hipFuncAttributeMaxDynamicSharedMemorySize, LDS_BYTES) != hipSuccess) { fprintf(stderr, "kernel_launch: hipFuncSetAttribute failed\n"); ready = -1; return; }
        int per_cu = 0;
        if (hipOccupancyMaxActiveBlocksPerMultiprocessor(&per_cu, (const void*)fwd_kernel, NTHREADS, LDS_BYTES) != hipSuccess || per_cu < 1) fprintf(stderr, "kernel_launch: occupancy query says %d blocks per CU\n", per_cu);
        (void)hipGetLastError();
        ready = 1;
    }
    if (ready < 0) return;
    if (hipMemsetAsync((char*)d_ws + OFF_BAR, 0, BAR_BYTES, stream) != hipSuccess) { fprintf(stderr, "kernel_launch: memset failed\n"); return; }
    Params p{};
    for (int i = 0; i < 19; ++i) p.in[i] = (const float*)d_in[i];
    p.out = (float*)d_out; p.ws = (unsigned char*)d_ws;
#if MODE_MULTI
    for (int ph = 0; ph < N_PHASES; ++ph) { p.ph_lo = ph; p.ph_hi = ph + 1; hipLaunchKernelGGL(fwd_kernel, dim3(NBLOCKS), dim3(NTHREADS), LDS_BYTES, stream, p); }
#else
    p.ph_lo = 0; p.ph_hi = N_PHASES;
    void* args[] = {&p};
    hipError_t e = hipLaunchCooperativeKernel((const void*)fwd_kernel, dim3(NBLOCKS), dim3(NTHREADS), args, LDS_BYTES, stream);
    if (e != hipSuccess) fprintf(stderr, "cooperative launch failed: %s\n", hipGetErrorString(e));
#endif
}
```

```cpp
#include <hip/hip_runtime.h>
#include <hip/hip_cooperative_groups.h>
#include <cstdio>
namespace cg = cooperative_groups;

#ifndef PROBE_DUP
#define PROBE_DUP -1
#endif
#ifndef PROBE_SYNCS
#define PROBE_SYNCS 0
#endif
#ifndef MODE_MULTI
#define MODE_MULTI 0
#endif

#define LAS __attribute__((address_space(3)))
typedef unsigned short bf16_t;
typedef short bf16x8 __attribute__((ext_vector_type(8)));
typedef float f32x4 __attribute__((ext_vector_type(4)));
typedef unsigned u32x4 __attribute__((ext_vector_type(4)));
typedef unsigned u32x2 __attribute__((ext_vector_type(2)));

constexpr int DM = 2048, CH = 16384, NCHUNK = 3, DFF = 8192;
constexpr int ZW = 9216;
constexpr int ZQ = 1024, ZK = 2048, ZG = 3072;
constexpr int XW = 2560;
constexpr float EPS = 1e-6f;
constexpr int NTHREADS = 512, NBLOCKS = 256, NWAVES_TOTAL = 2048;
constexpr int LDS_BAR_OFF = 15360 + 131072;
constexpr int LDS_BYTES = LDS_BAR_OFF + 16;

constexpr size_t SZ_WIN = (size_t)10752 * 2048 * 2, SZ_W1 = (size_t)8192 * 2048 * 2, SZ_W2 = SZ_W1, SZ_WO = (size_t)2048 * 2048 * 2, SZ_WCAT = (size_t)2048 * XW * 2;
constexpr size_t SZ_LAYER = SZ_WIN + SZ_W1 + SZ_W2 + SZ_WO + SZ_WCAT;
constexpr size_t OFF_W = 0;
constexpr size_t OFF_FM = OFF_W + 2 * SZ_LAYER;
constexpr size_t OFF_H = OFF_FM + (size_t)4096 * 2048 * 2;
constexpr size_t OFF_Z = OFF_H + (size_t)CH * 2048 * 2;
constexpr size_t OFF_TT = OFF_Z + (size_t)CH * ZW * 2;
constexpr size_t OFF_E = OFF_TT + (size_t)1536 * CH * 2;
constexpr size_t OFF_X = OFF_E + (size_t)CH * 1024 * 2;
constexpr size_t OFF_M = OFF_X + (size_t)CH * XW * 2;
constexpr size_t OFF_BAR = OFF_M + (size_t)CH * 2048 * 2;
constexpr size_t BAR_BYTES = 16384;
constexpr size_t OFF_SS1 = OFF_BAR + BAR_BYTES;
constexpr size_t OFF_SS2 = OFF_SS1 + (size_t)CH * 4;
constexpr size_t WS_END = OFF_SS2 + (size_t)CH * 4;

struct Params { const float* in[19]; float* out; unsigned char* ws; int ph_lo, ph_hi; };

__device__ __forceinline__ int opaque_tid(int wid) { int wv_ = wid; asm volatile("" : "+v"(wv_)); wv_ = __builtin_amdgcn_readfirstlane(wv_); unsigned ones = ~0u; asm volatile("" : "+s"(ones)); int t = (wv_ << 6) | (int)__builtin_amdgcn_mbcnt_hi(ones, __builtin_amdgcn_mbcnt_lo(ones, 0u)); asm volatile("" : "+v"(t)); return t; }
__device__ __forceinline__ LAS unsigned char* local_lds(LAS unsigned char* l) { unsigned u = (unsigned)(size_t)l; asm volatile("" : "+s"(u)); return (LAS unsigned char*)(size_t)u; }
__device__ __forceinline__ unsigned cvt_pk_bf16(float lo, float hi) { unsigned r; asm("v_cvt_pk_bf16_f32 %0, %1, %2" : "=v"(r) : "v"(lo), "v"(hi)); return r; }
__device__ __forceinline__ float bf_lo(unsigned w) { return __uint_as_float(w << 16); }
__device__ __forceinline__ float bf_hi(unsigned w) { return __uint_as_float(w & 0xffff0000u); }
__device__ __forceinline__ float bf2f(bf16_t b) { return __uint_as_float(((unsigned)b) << 16); }
__device__ __forceinline__ float rstd_of(float ss) { return rsqrtf(ss * (1.0f / DM) + EPS); }
__device__ __forceinline__ float sigmoidf_(float x) { return __builtin_amdgcn_rcpf(1.0f + __expf(-x)); }
__device__ __forceinline__ u32x4 pack8(const f32x4 a, const f32x4 b) { u32x4 w; w.x = cvt_pk_bf16(a[0], a[1]); w.y = cvt_pk_bf16(a[2], a[3]); w.z = cvt_pk_bf16(b[0], b[1]); w.w = cvt_pk_bf16(b[2], b[3]); return w; }
__device__ __forceinline__ void unpack8(const u32x4 w, f32x4& a, f32x4& b) { a[0] = bf_lo(w.x); a[1] = bf_hi(w.x); a[2] = bf_lo(w.y); a[3] = bf_hi(w.y); b[0] = bf_lo(w.z); b[1] = bf_hi(w.z); b[2] = bf_lo(w.w); b[3] = bf_hi(w.w); }

namespace pg8 {
constexpr int BM = 256, BK = 64, HALF = 128, HTB = HALF * BK * 2, STAGE_BYTES = 8 * HTB, NXCD = 8, WGM = 8;
__device__ __forceinline__ int lds_byte(int r, int c) { const int st = (r >> 4) * 2 + (c >> 5), rr = r & 15, cc = c & 31, ob = rr * 64 + cc * 2; return st * 1024 + (ob ^ (((ob >> 9) & 1) << 5)); }
__device__ __forceinline__ void stage_rc(int b, int& R, int& C) { const int st = b / 1024, sb = b % 1024, swz = sb ^ (((sb >> 9) & 1) << 5); R = (st >> 1) * 16 + swz / 64; C = (st & 1) * 32 + (swz % 64) / 2; }
__device__ __forceinline__ int perm32(int rho) { const int n = rho >> 4, i = rho & 15; return 8 * (i >> 2) + 4 * n + (i & 3); }

struct Unit { int pm, pn, aux, nt; const char* A; const char* B; };

__device__ __forceinline__ void remap(int L, int nM, int nN, int& pm, int& pn, const int WGM = 8) {
    const int nwg = nM * nN; int wgid = L;
    { const int q = nwg / NXCD, r = nwg % NXCD, xcd = wgid % NXCD, off = wgid / NXCD; wgid = (xcd < r ? xcd * (q + 1) : r * (q + 1) + (xcd - r) * q) + off; }
    const int nig = WGM * nN, gid = wgid / nig, fm = gid * WGM, gsz = (nM - fm) < WGM ? (nM - fm) : WGM;
    pm = fm + ((wgid % nig) % gsz); pn = (wgid % nig) / gsz;
}

template <class Epi, class Sched>
__device__ __forceinline__ void gemm_phase(LAS unsigned char* lds_in, const int lda, const int ldb, const Sched& S, const Epi& E, const int WID) {
    unsigned lds_u = (unsigned)(size_t)lds_in; asm volatile("" : "+s"(lds_u));
    LAS unsigned char* lds = (LAS unsigned char*)(size_t)lds_u;
    const int tid = opaque_tid(WID), wid = __builtin_amdgcn_readfirstlane(tid >> 6), lane = tid & 63, wr = wid >> 2, wc = wid & 3, fr = lane & 15, fq = lane >> 4;
    unsigned voffA[2], voffB[2];
#pragma unroll
    for (int i = 0; i < 2; ++i) { int R, C; stage_rc(tid * 16 + i * 8192, R, C); const int Rb = Epi::PERM ? ((R & ~31) + perm32(R & 31)) : R;
        voffA[i] = (unsigned)(R * lda + C) * 2u; voffB[i] = (unsigned)(Rb * ldb + C) * 2u; }
    const size_t kstep = (size_t)(BK * 2);
    const size_t hstepA = (size_t)HALF * lda * 2, hstepB = (size_t)HALF * ldb * 2;
    const unsigned ldsw = (unsigned)wid * 1024u;
    const int aoff = lds_byte(wr * 64 + fr, fq * 8), boff = lds_byte(wc * 32 + fr, fq * 8);
#define PG8_SA(b, h) (((b) * 2 + (h)) * HTB)
#define PG8_SB(b, h) ((4 + (b) * 2 + (h)) * HTB)
#define PG8_STAGE(bufoff, gbase, voff) do { _Pragma("unroll") for (int _i = 0; _i < 2; ++_i) \
        __builtin_amdgcn_global_load_lds((const unsigned*)((const char*)(gbase) + (voff)[_i]), (LAS unsigned*)(lds + (bufoff) + ldsw + _i * 8192), 16, 0, 0); } while (0)
#define PG8_LDA(dst, b, h) do { _Pragma("unroll") for (int m = 0; m < 4; ++m) _Pragma("unroll") for (int k = 0; k < 2; ++k) dst[m][k] = *(const LAS bf16x8*)(lds + PG8_SA(b, h) + aoff + m * 2048 + k * 1024); } while (0)
#define PG8_LDB(dst, b, h) do { _Pragma("unroll") for (int n = 0; n < 2; ++n) _Pragma("unroll") for (int k = 0; k < 2; ++k) dst[n][k] = *(const LAS bf16x8*)(lds + PG8_SB(b, h) + boff + n * 2048 + k * 1024); } while (0)
#define PG8_MMA(ai, bj, At, Bt) do { __builtin_amdgcn_s_setprio(1); _Pragma("unroll") for (int m = 0; m < 4; ++m) _Pragma("unroll") for (int n = 0; n < 2; ++n) _Pragma("unroll") for (int k = 0; k < 2; ++k) \
        acc[ai][bj][m][n] = __builtin_amdgcn_mfma_f32_16x16x32_bf16(Bt[n][k], At[m][k], acc[ai][bj][m][n], 0, 0, 0); __builtin_amdgcn_s_setprio(0); } while (0)
#define PG8_WAIT_V(n) asm volatile("s_waitcnt vmcnt(" #n ")" ::: "memory")
#define PG8_WAIT_L(n) asm volatile("s_waitcnt lgkmcnt(" #n ")" ::: "memory")
#define PG8_BAR __builtin_amdgcn_s_barrier()
#define PG8_SCHED __builtin_amdgcn_sched_barrier(0)
    Unit cur, nxt; int ui = 0;
    if (!S.next(0, cur)) return;
    f32x4 acc[2][2][4][2];
#pragma unroll
    for (int a = 0; a < 2; ++a)
#pragma unroll
        for (int b = 0; b < 2; ++b)
#pragma unroll
            for (int m = 0; m < 4; ++m)
#pragma unroll
                for (int n = 0; n < 2; ++n) acc[a][b][m][n] = (f32x4){0.f, 0.f, 0.f, 0.f};
    bf16x8 At[4][2], B0[2][2], B1[2][2];
    const char* cA = cur.A; const char* cB = cur.B;
    PG8_STAGE(PG8_SB(0, 0), cB, voffB); PG8_STAGE(PG8_SA(0, 0), cA, voffA); PG8_STAGE(PG8_SB(0, 1), cB + hstepB, voffB); PG8_STAGE(PG8_SA(0, 1), cA + hstepA, voffA);
    if (wr == 1) PG8_BAR;
    PG8_WAIT_V(4); PG8_BAR;
    PG8_STAGE(PG8_SB(1, 0), cB + kstep, voffB); PG8_STAGE(PG8_SA(1, 0), cA + kstep, voffA); PG8_STAGE(PG8_SB(1, 1), cB + hstepB + kstep, voffB);
    PG8_WAIT_V(6); PG8_BAR;
    for (;;) {
        const bool has_next = S.next(ui + 1, nxt);
        const char* nA = has_next ? nxt.A : cA; const char* nB = has_next ? nxt.B : cB;
        const int nt = cur.nt;
        for (int sg = 0; sg < (Epi::HAS_MID ? 3 : 1); ++sg) {
        const int tb = Epi::HAS_MID ? (sg == 0 ? 0 : (sg == 1 ? 16 : 24)) : 0, te = Epi::HAS_MID ? (sg == 0 ? 16 : (sg == 1 ? 24 : nt)) : nt;
        if constexpr (Epi::HAS_MID) { if (sg > 0) { PG8_SCHED; E.mid(acc, cur, tb, wr, wc, fr, fq); PG8_SCHED; } }
        for (int t = tb; t < te; t += 2) {
            const bool last = (t == nt - 2);
            const char* a1 = cA + (size_t)(t + 1) * kstep;
            const char* a2 = last ? nA : cA + (size_t)(t + 2) * kstep; const char* b2 = last ? nB : cB + (size_t)(t + 2) * kstep;
            const char* a3 = a2 + kstep; const char* b3 = b2 + kstep;
            PG8_LDB(B0, 0, 0); PG8_SCHED; PG8_LDA(At, 0, 0); PG8_STAGE(PG8_SA(1, 1), a1 + hstepA, voffA);
            PG8_WAIT_L(8); PG8_BAR; PG8_WAIT_L(0); PG8_MMA(0, 0, At, B0); PG8_BAR; PG8_SCHED;
            PG8_LDB(B1, 0, 1); PG8_STAGE(PG8_SB(0, 0), b2, voffB);
            PG8_BAR; PG8_WAIT_L(0); PG8_MMA(0, 1, At, B1); PG8_BAR;
            PG8_LDA(At, 0, 1); PG8_STAGE(PG8_SA(0, 0), a2, voffA);
            PG8_BAR; PG8_WAIT_L(0); PG8_MMA(1, 0, At, B0); PG8_BAR; PG8_SCHED;
            PG8_STAGE(PG8_SB(0, 1), b2 + hstepB, voffB);
            PG8_WAIT_V(6); PG8_BAR; PG8_MMA(1, 1, At, B1); PG8_BAR;
            PG8_LDB(B0, 1, 0); PG8_SCHED; PG8_LDA(At, 1, 0); PG8_STAGE(PG8_SA(0, 1), a2 + hstepA, voffA);
            PG8_WAIT_L(8); PG8_BAR; PG8_WAIT_L(0); PG8_MMA(0, 0, At, B0); PG8_BAR; PG8_SCHED;
            PG8_LDB(B1, 1, 1); PG8_STAGE(PG8_SB(1, 0), b3, voffB);
            PG8_BAR; PG8_WAIT_L(0); PG8_MMA(0, 1, At, B1); PG8_BAR;
            PG8_LDA(At, 1, 1); PG8_STAGE(PG8_SA(1, 0), a3, voffA);
            PG8_BAR; PG8_WAIT_L(0); PG8_MMA(1, 0, At, B0); PG8_BAR; PG8_SCHED;
            PG8_STAGE(PG8_SB(1, 1), b3 + hstepB, voffB);
            PG8_WAIT_V(6); PG8_BAR; PG8_MMA(1, 1, At, B1); PG8_BAR;
        }
        }
        E(acc, cur, wr, wc, fr, fq);
        if (!has_next) break;
#pragma unroll
        for (int a = 0; a < 2; ++a)
#pragma unroll
            for (int b = 0; b < 2; ++b)
#pragma unroll
                for (int m = 0; m < 4; ++m)
#pragma unroll
                    for (int n = 0; n < 2; ++n) acc[a][b][m][n] = (f32x4){0.f, 0.f, 0.f, 0.f};
        cur = nxt; cA = nA; cB = nB; ++ui;
    }
    PG8_WAIT_V(0);
    if (wr == 0) PG8_BAR;
    PG8_BAR;
#undef PG8_SA
#undef PG8_SB
#undef PG8_STAGE
#undef PG8_LDA
#undef PG8_LDB
#undef PG8_MMA
#undef PG8_WAIT_V
#undef PG8_WAIT_L
#undef PG8_BAR
#undef PG8_SCHED
}
}
using pg8::Unit;
typedef f32x4 AccT[2][2][4][2];

struct SchedB {
    const char* H; const char* W; int G, c;
    __device__ __forceinline__ bool next(int i, Unit& u) const {
        const int L = i * G + c; if (L >= 2688) return false; u.nt = 32;
        if (L < 2304) { pg8::remap(L, 64, 36, u.pm, u.pn, 4); u.aux = 0; u.A = H + (size_t)u.pm * 256 * 2048 * 2; u.B = W + (size_t)(1536 + u.pn * 256) * 2048 * 2; }
        else { pg8::remap(L - 2304, 6, 64, u.pm, u.pn); u.aux = 1; u.A = W + (size_t)u.pm * 256 * 2048 * 2; u.B = H + (size_t)u.pn * 256 * 2048 * 2; }
        return true; }
};
struct SchedDFT {
    const char* Fm; const char* TT; int G, c;
    __device__ __forceinline__ bool next(int i, Unit& u) const {
        const int L = i * G + c; if (L >= 256) return false; int pmv, pn; pg8::remap(L, 128, 2, pmv, pn);
        const int pb = pmv >> 4; u.pm = pmv & 15; u.pn = pn; u.aux = pb; u.nt = 32;
        u.A = Fm + (size_t)u.pm * 256 * 2048 * 2; u.B = TT + ((size_t)pn * 256 * CH + (size_t)pb * 2048) * 2; return true; }
};
struct SchedMrg {
    const char* X; const char* W; int G, c;
    __device__ __forceinline__ bool next(int i, Unit& u) const {
        const int ti = i / 3, seg = i - ti * 3; const int L = ti * G + c; if (L >= 512) return false; pg8::remap(L, 64, 8, u.pm, u.pn);
        const int koff = seg == 0 ? 0 : (seg == 1 ? 1024 : 1536); u.nt = seg == 1 ? 8 : 16; u.aux = seg;
        u.A = X + ((size_t)u.pm * 256 * XW + koff) * 2; u.B = W + ((size_t)u.pn * 256 * XW + koff) * 2; return true; }
};
struct SchedPlain { const char* A; const char* B; int nM, nN, lda, ldb, nt, G, c, wgm;
    __device__ __forceinline__ bool next(int i, Unit& u) const {
        const int L = i * G + c; if (L >= nM * nN) return false; pg8::remap(L, nM, nN, u.pm, u.pn, wgm); u.aux = 0; u.nt = nt;
        u.A = A + (size_t)u.pm * 256 * lda * 2; u.B = B + (size_t)u.pn * 256 * ldb * 2; return true; }
};

struct EpiB { static constexpr bool PERM = true, HAS_MID = false; bf16_t* Z; bf16_t* TT; const float* bg; const float* SS; int sample;
    __device__ __forceinline__ void operator()(const AccT& acc, const Unit& u, int wr, int wc, int fr, int fq) const {
        const int row0 = u.pm * 256 + wr * 64 + fr, col0 = u.pn * 256 + wc * 32 + 8 * fq;
        if (u.aux == 0) {
            const bool gate = u.pn >= 12;
            float rsv[2][4]; f32x4 bb0[2], bb1[2];
#pragma unroll
            for (int ai = 0; ai < 2; ++ai)
#pragma unroll
                for (int m = 0; m < 4; ++m) rsv[ai][m] = SS[row0 + ai * 128 + m * 16];
#pragma unroll
            for (int bj = 0; bj < 2; ++bj) { bb0[bj] = (f32x4){0.f, 0.f, 0.f, 0.f}; bb1[bj] = bb0[bj];
                if (gate) { bb0[bj] = *(const f32x4*)(bg + col0 + bj * 128 - ZG); bb1[bj] = *(const f32x4*)(bg + col0 + bj * 128 - ZG + 4); } }
#pragma unroll
            for (int bj = 0; bj < 2; ++bj) {
                const f32x4 b0 = bb0[bj], b1 = bb1[bj];
#pragma unroll
                for (int ai = 0; ai < 2; ++ai)
#pragma unroll
                    for (int m = 0; m < 4; ++m) {
                        const float rs = rstd_of(rsv[ai][m]);
                        f32x4 v0 = acc[ai][bj][m][0] * rs, v1 = acc[ai][bj][m][1] * rs;
                        if (gate) {
#pragma unroll
                            for (int j = 0; j < 4; ++j) { v0[j] = sigmoidf_(v0[j] + b0[j]); v1[j] = sigmoidf_(v1[j] + b1[j]); } }
                        *(u32x4*)(Z + (size_t)(row0 + ai * 128 + m * 16) * ZW + col0 + bj * 128) = pack8(v0, v1);
                    }
            }
        } else {
            const bool scat = sample && u.pm < 2;
            f32x4 rs0[2], rs1[2];
#pragma unroll
            for (int bj = 0; bj < 2; ++bj) { const f32x4 a = *(const f32x4*)(SS + col0 + bj * 128), b = *(const f32x4*)(SS + col0 + bj * 128 + 4);
#pragma unroll
                for (int j = 0; j < 4; ++j) { rs0[bj][j] = rstd_of(a[j]); rs1[bj][j] = rstd_of(b[j]); } }
#pragma unroll
            for (int ai = 0; ai < 2; ++ai)
#pragma unroll
                for (int m = 0; m < 4; ++m) {
                    bf16_t* rp = TT + (size_t)(row0 + ai * 128 + m * 16) * CH;
#pragma unroll
                    for (int bj = 0; bj < 2; ++bj) {
                        const u32x4 w = pack8(acc[ai][bj][m][0] * rs0[bj], acc[ai][bj][m][1] * rs1[bj]);
                        const int tok = col0 + bj * 128;
                        if (!scat) *(u32x4*)(rp + tok) = w;
                        else {
                            const int b = tok >> 13, t = (tok & 8191) >> 2; bf16_t* q = rp + (b << 13) + t;
                            q[0] = (bf16_t)(w.x & 0xffff); q[2048] = (bf16_t)(w.x >> 16); q[4096] = (bf16_t)(w.y & 0xffff); q[6144] = (bf16_t)(w.y >> 16);
                            q[1] = (bf16_t)(w.z & 0xffff); q[2049] = (bf16_t)(w.z >> 16); q[4097] = (bf16_t)(w.w & 0xffff); q[6145] = (bf16_t)(w.w >> 16);
                        }
                    }
                }
        }
    }
};
struct EpiDFT { static constexpr bool PERM = true, HAS_MID = false; bf16_t* X; bf16_t* E; int sample;
    __device__ __forceinline__ void operator()(const AccT& acc, const Unit& u, int wr, int wc, int fr, int fq) const {
        const int part = u.pm >> 3, s0 = (u.pm & 7) * 256 + wr * 64 + fr, pb = u.aux;
#pragma unroll
        for (int bj = 0; bj < 2; ++bj) {
            const int dcol = (u.pn * 2 + bj) * 256 + part * 128 + wc * 32 + 8 * fq;
#pragma unroll
            for (int ai = 0; ai < 2; ++ai)
#pragma unroll
                for (int m = 0; m < 4; ++m) {
                    const size_t tok = (size_t)pb * 2048 + s0 + ai * 128 + m * 16;
                    bf16_t* dst = sample ? (E + tok * 1024 + dcol) : (X + tok * XW + dcol);
                    *(u32x4*)dst = pack8(acc[ai][bj][m][0], acc[ai][bj][m][1]);
                }
        }
    }
};
struct EpiMrg { static constexpr bool PERM = true, HAS_MID = false; const bf16_t* Z; bf16_t* M;
    __device__ __forceinline__ void operator()(const AccT& acc, const Unit& u, int wr, int wc, int fr, int fq) const {
        const int row0 = u.pm * 256 + wr * 64 + fr, col0 = u.pn * 256 + wc * 32 + 8 * fq, seg = u.aux;
#pragma unroll
        for (int ai = 0; ai < 2; ++ai)
#pragma unroll
            for (int m = 0; m < 4; ++m) {
                const size_t row = (size_t)(row0 + ai * 128 + m * 16);
#pragma unroll
                for (int bj = 0; bj < 2; ++bj) {
                    const u32x4 gw = *(const u32x4*)(Z + row * ZW + ZG + seg * 2048 + col0 + bj * 128);
                    f32x4 g0, g1; unpack8(gw, g0, g1);
                    f32x4 p0 = {0.f, 0.f, 0.f, 0.f}, p1 = p0;
                    bf16_t* mp = M + row * 2048 + col0 + bj * 128;
                    if (seg) { const u32x4 pw = *(const u32x4*)mp; unpack8(pw, p0, p1); }
                    *(u32x4*)mp = pack8(p0 + g0 * acc[ai][bj][m][0], p1 + g1 * acc[ai][bj][m][1]);
                }
                asm volatile("" ::: "memory");
            }
    }
};
struct EpiMrg2 { static constexpr bool PERM = true, HAS_MID = true; const bf16_t* Z; bf16_t* M;
    __device__ __forceinline__ void mid(AccT& acc, const Unit& u, int t, int wr, int wc, int fr, int fq) const {
        int row0 = u.pm * 256 + wr * 64 + fr, col0 = u.pn * 256 + wc * 32 + 8 * fq; const int seg = (t == 16) ? 0 : 1;
        asm volatile("" : "+v"(row0), "+v"(col0));
#pragma unroll
        for (int ai = 0; ai < 2; ++ai) {
            u32x4 ga[4][2], gb[4][2];
#pragma unroll
            for (int m = 0; m < 4; ++m)
#pragma unroll
                for (int bj = 0; bj < 2; ++bj) { const bf16_t* gp = Z + (size_t)(row0 + ai * 128 + m * 16) * ZW + ZG + seg * 2048 + col0 + bj * 128; ga[m][bj] = *(const u32x4*)gp; gb[m][bj] = *(const u32x4*)(gp + 2048); }
#pragma unroll
            for (int m = 0; m < 4; ++m)
#pragma unroll
                for (int bj = 0; bj < 2; ++bj) {
                    f32x4 a0, a1, b0, b1; unpack8(ga[m][bj], a0, a1); unpack8(gb[m][bj], b0, b1);
#pragma unroll
                    for (int j = 0; j < 4; ++j) { a0[j] = fmaxf(a0[j], 1e-20f) * __builtin_amdgcn_rcpf(fmaxf(b0[j], 1e-20f)); a1[j] = fmaxf(a1[j], 1e-20f) * __builtin_amdgcn_rcpf(fmaxf(b1[j], 1e-20f)); }
                    acc[ai][bj][m][0] *= a0; acc[ai][bj][m][1] *= a1;
                }
            asm volatile("" ::: "memory");
        }
    }
    __device__ __forceinline__ void operator()(const AccT& acc, const Unit& u, int wr, int wc, int fr, int fq) const {
        int row0 = u.pm * 256 + wr * 64 + fr, col0 = u.pn * 256 + wc * 32 + 8 * fq;
        asm volatile("" : "+v"(row0), "+v"(col0));
        u32x4 gw[2][4][2];
#pragma unroll
        for (int ai = 0; ai < 2; ++ai)
#pragma unroll
            for (int m = 0; m < 4; ++m)
#pragma unroll
                for (int bj = 0; bj < 2; ++bj) gw[ai][m][bj] = *(const u32x4*)(Z + (size_t)(row0 + ai * 128 + m * 16) * ZW + ZG + 2 * 2048 + col0 + bj * 128);
#pragma unroll
        for (int ai = 0; ai < 2; ++ai)
#pragma unroll
            for (int m = 0; m < 4; ++m) {
                const size_t row = (size_t)(row0 + ai * 128 + m * 16);
#pragma unroll
                for (int bj = 0; bj < 2; ++bj) {
                    f32x4 g0, g1; unpack8(gw[ai][m][bj], g0, g1);
#pragma unroll
                    for (int j = 0; j < 4; ++j) { g0[j] = fmaxf(g0[j], 1e-20f); g1[j] = fmaxf(g1[j], 1e-20f); }
                    *(u32x4*)(M + row * 2048 + col0 + bj * 128) = pack8(g0 * acc[ai][bj][m][0], g1 * acc[ai][bj][m][1]);
                }
            }
    }
};
struct EpiRes { static constexpr bool PERM = true, HAS_MID = false; bf16_t* Hb; float* outF; float* SS;
    __device__ __forceinline__ void operator()(const AccT& acc, const Unit& u, int wr, int wc, int fr, int fq) const {
        int row0 = u.pm * 256 + wr * 64 + fr, col0 = u.pn * 256 + wc * 32 + 8 * fq;
        asm volatile("" : "+v"(row0), "+v"(col0));
        u32x4 bw[2][4][2];
#pragma unroll
        for (int ai = 0; ai < 2; ++ai)
#pragma unroll
            for (int m = 0; m < 4; ++m)
#pragma unroll
                for (int bj = 0; bj < 2; ++bj) bw[ai][m][bj] = *(const u32x4*)(Hb + (size_t)(row0 + ai * 128 + m * 16) * 2048 + col0 + bj * 128);
#pragma unroll
        for (int ai = 0; ai < 2; ++ai) {
#pragma unroll
            for (int m = 0; m < 4; ++m) {
                const int row = row0 + ai * 128 + m * 16; const size_t off = (size_t)row * 2048 + col0; float ss = 0.f;
#pragma unroll
                for (int bj = 0; bj < 2; ++bj) {
                    f32x4 b0, b1; unpack8(bw[ai][m][bj], b0, b1);
                    const f32x4 o0 = b0 + acc[ai][bj][m][0], o1 = b1 + acc[ai][bj][m][1];
                    if (outF) { *(f32x4*)(outF + off + bj * 128) = o0; *(f32x4*)(outF + off + bj * 128 + 4) = o1; }
                    else { *(u32x4*)(Hb + off + bj * 128) = pack8(o0, o1);
                        ss += (o0[0] * o0[0] + o0[1] * o0[1]) + (o0[2] * o0[2] + o0[3] * o0[3]) + (o1[0] * o1[0] + o1[1] * o1[1]) + (o1[2] * o1[2] + o1[3] * o1[3]); }
                }
                if (!outF) { ss += __shfl_xor(ss, 16); ss += __shfl_xor(ss, 32); if (fq == 0) atomicAdd(SS + row, ss); }
            }
        }
    }
};
struct EpiRelu2 { static constexpr bool PERM = true, HAS_MID = false; bf16_t* Hd; const float* SS;
    __device__ __forceinline__ void operator()(const AccT& acc, const Unit& u, int wr, int wc, int fr, int fq) const {
        const int row0 = u.pm * 256 + wr * 64 + fr, col0 = u.pn * 256 + wc * 32 + 8 * fq;
        float rsv[2][4];
#pragma unroll
        for (int ai = 0; ai < 2; ++ai)
#pragma unroll
            for (int m = 0; m < 4; ++m) rsv[ai][m] = SS[row0 + ai * 128 + m * 16];
#pragma unroll
        for (int ai = 0; ai < 2; ++ai)
#pragma unroll
            for (int m = 0; m < 4; ++m) {
                const float rs = rstd_of(rsv[ai][m]);
#pragma unroll
                for (int bj = 0; bj < 2; ++bj) {
                    f32x4 v0 = acc[ai][bj][m][0] * rs, v1 = acc[ai][bj][m][1] * rs;
#pragma unroll
                    for (int j = 0; j < 4; ++j) { const float a = fmaxf(v0[j], 0.f), b = fmaxf(v1[j], 0.f); v0[j] = a * a; v1[j] = b * b; }
                    *(u32x4*)(Hd + (size_t)(row0 + ai * 128 + m * 16) * DFF + col0 + bj * 128) = pack8(v0, v1);
                }
            }
    }
};

struct TrTask { const float* src; size_t sld; bf16_t* dst; size_t dld; const float* gk; };
__device__ __forceinline__ int winT_row(int n0) {
    if (n0 < 512) return n0; if (n0 < 1024) return 1536 + (n0 - 512); if (n0 < 1536) return 2048 + (n0 - 1024);
    if (n0 < 2560) return 2560 + (n0 - 1536); if (n0 < 3584) return 3584 + (n0 - 2560); if (n0 < 4608) return 512 + (n0 - 3584); return n0;
}
__device__ __forceinline__ TrTask tr_decode(const Params& p, int t) {
    const int l = t / 30720; int r = t - l * 30720;
    unsigned char* wl = p.ws + OFF_W + (size_t)l * SZ_LAYER;
    bf16_t* WinT = (bf16_t*)wl; bf16_t* W1T = (bf16_t*)(wl + SZ_WIN); bf16_t* W2T = (bf16_t*)(wl + SZ_WIN + SZ_W1); bf16_t* WoT = (bf16_t*)(wl + SZ_WIN + SZ_W1 + SZ_W2); bf16_t* WcT = (bf16_t*)(wl + SZ_WIN + SZ_W1 + SZ_W2 + SZ_WO);
    if (r < 10752) { const int kt = r / 336, nt = r - kt * 336; return TrTask{p.in[3] + (size_t)l * 2048 * 10752 + (size_t)kt * 64 * 10752 + nt * 32, 10752, WinT + (size_t)winT_row(nt * 32) * 2048 + kt * 64, 2048, p.in[2] + l * DM + kt * 64}; }
    r -= 10752;
    if (r < 8192) { const int kt = r >> 8, nt = r & 255; return TrTask{p.in[17] + (size_t)l * 2048 * 8192 + (size_t)kt * 64 * 8192 + nt * 32, 8192, W1T + (size_t)nt * 32 * 2048 + kt * 64, 2048, p.in[16] + l * DM + kt * 64}; }
    r -= 8192;
    if (r < 8192) { const int kt = r >> 6, nt = r & 63; return TrTask{p.in[18] + (size_t)l * 8192 * 2048 + (size_t)kt * 64 * 2048 + nt * 32, 2048, W2T + (size_t)nt * 32 * 8192 + kt * 64, 8192, nullptr}; }
    r -= 8192;
    if (r < 2048) { const int kt = r >> 6, nt = r & 63; return TrTask{p.in[15] + (size_t)l * 2048 * 2048 + (size_t)kt * 64 * 2048 + nt * 32, 2048, WoT + (size_t)nt * 32 * 2048 + kt * 64, 2048, nullptr}; }
    r -= 2048;
    if (r < 512) { const int kt = r >> 6, nt = r & 63; return TrTask{p.in[10] + (size_t)l * 512 * 2048 + (size_t)kt * 64 * 2048 + nt * 32, 2048, WcT + (size_t)nt * 32 * XW + 1024 + kt * 64, XW, nullptr}; }
    r -= 512;
    { const int kt = r >> 6, nt = r & 63; return TrTask{p.in[14] + (size_t)l * 1024 * 2048 + (size_t)kt * 64 * 2048 + nt * 32, 2048, WcT + (size_t)nt * 32 * XW + 1536 + kt * 64, XW, nullptr}; }
}
__device__ void ph_prep(const Params& p, LAS unsigned char* lds_in, const int WID) {
    LAS unsigned char* lds = local_lds(lds_in);
    const int tid = opaque_tid(WID), lane = tid & 63, wv = __builtin_amdgcn_readfirstlane(tid >> 6);
    LAS float* tile = (LAS float*)lds + wv * (64 * 33);
    const int ri = lane >> 3, j4 = (lane & 7) * 4, k8 = (lane & 7) * 8;
    {
        int t = blockIdx.x * 8 + wv;
        TrTask cur = tr_decode(p, t);
        f32x4 v[8], gA, gB;
#pragma unroll
        for (int q = 0; q < 8; ++q) v[q] = *(const f32x4*)(cur.src + (size_t)(q * 8 + ri) * cur.sld + j4);
        { const float* gp = cur.gk ? cur.gk : p.in[2];
#pragma unroll
          for (int q = 0; q < 4; ++q) { gA[q] = gp[q * 8 + ri]; gB[q] = gp[(q + 4) * 8 + ri]; }
          if (!cur.gk) { gA = (f32x4){1.f, 1.f, 1.f, 1.f}; gB = gA; } }
        for (; t < 2 * 30720; t += NWAVES_TOTAL) {
            const int tn = t + NWAVES_TOTAL; const bool more = tn < 2 * 30720;
            const TrTask nxt = tr_decode(p, more ? tn : t);
            f32x4 vn[8], hA, hB;
#pragma unroll
            for (int q = 0; q < 8; ++q) vn[q] = *(const f32x4*)(nxt.src + (size_t)(q * 8 + ri) * nxt.sld + j4);
            { const float* gp = nxt.gk ? nxt.gk : p.in[2];
#pragma unroll
              for (int q = 0; q < 4; ++q) { hA[q] = gp[q * 8 + ri]; hB[q] = gp[(q + 4) * 8 + ri]; }
              if (!nxt.gk) { hA = (f32x4){1.f, 1.f, 1.f, 1.f}; hB = hA; } }
#pragma unroll
            for (int q = 0; q < 8; ++q) { const int i = q * 8 + ri; const f32x4 x = v[q] * (q < 4 ? gA[q & 3] : gB[q & 3]); tile[i * 33 + j4] = x[0]; tile[i * 33 + j4 + 1] = x[1]; tile[i * 33 + j4 + 2] = x[2]; tile[i * 33 + j4 + 3] = x[3]; }
            asm volatile("s_waitcnt lgkmcnt(0)" ::: "memory"); __builtin_amdgcn_wave_barrier();
#pragma unroll
            for (int q = 0; q < 4; ++q) { const int j = q * 8 + ri; f32x4 a, b;
#pragma unroll
                for (int e = 0; e < 4; ++e) { a[e] = tile[(k8 + e) * 33 + j]; b[e] = tile[(k8 + 4 + e) * 33 + j]; }
                *(u32x4*)(cur.dst + (size_t)j * cur.dld + k8) = pack8(a, b); }
            asm volatile("s_waitcnt lgkmcnt(0)" ::: "memory"); __builtin_amdgcn_wave_barrier();
            cur = nxt; gA = hA; gB = hB;
#pragma unroll
            for (int q = 0; q < 8; ++q) v[q] = vn[q];
        }
    }
    __syncthreads();
    LAS float* wt = (LAS float*)lds;
    LAS float* ctab = wt + 512 * 16;
    LAS float* stab = ctab + 128;
    if (tid < 128) { float sn, cs; sincospif((float)tid / 64.0f, &sn, &cs); ctab[tid] = cs; stab[tid] = sn; }
    for (int t = blockIdx.x; t < 2 * 128; t += gridDim.x) {
        const int l = t >> 7, e0 = (t & 127) * 16;
        __syncthreads();
        { const float* srow = p.in[5] + (size_t)l * 512 * 2048 + (size_t)tid * 2048 + e0;
#pragma unroll
          for (int q = 0; q < 4; ++q) *(LAS f32x4*)(wt + tid * 16 + q * 4) = *(const f32x4*)(srow + q * 4); }
        __syncthreads();
        bf16_t* WcT = (bf16_t*)(p.ws + OFF_W + (size_t)l * SZ_LAYER + SZ_WIN + SZ_W1 + SZ_W2 + SZ_WO);
#pragma unroll 1
        for (int q = 0; q < 2; ++q) {
            const int kp = tid + 512 * q, g = kp >> 8, part = (kp >> 7) & 1, c = kp & 127;
            f32x4 s0 = {0.f, 0.f, 0.f, 0.f}, s1 = s0, s2 = s0, s3 = s0;
            for (int m = 0; m < 128; ++m) {
                const int idx = (c * m) & 127; const float tw = part ? -stab[idx] : ctab[idx];
                const LAS float* wr_ = wt + (g * 128 + m) * 16;
                s0 += tw * *(const LAS f32x4*)wr_; s1 += tw * *(const LAS f32x4*)(wr_ + 4); s2 += tw * *(const LAS f32x4*)(wr_ + 8); s3 += tw * *(const LAS f32x4*)(wr_ + 12);
            }
            const float sc = 0.08838834764831845f;
#pragma unroll
            for (int e = 0; e < 4; ++e) {
                WcT[(size_t)(e0 + e) * XW + kp] = (bf16_t)(cvt_pk_bf16(s0[e] * sc, 0.f) & 0xffff);
                WcT[(size_t)(e0 + 4 + e) * XW + kp] = (bf16_t)(cvt_pk_bf16(s1[e] * sc, 0.f) & 0xffff);
                WcT[(size_t)(e0 + 8 + e) * XW + kp] = (bf16_t)(cvt_pk_bf16(s2[e] * sc, 0.f) & 0xffff);
                WcT[(size_t)(e0 + 12 + e) * XW + kp] = (bf16_t)(cvt_pk_bf16(s3[e] * sc, 0.f) & 0xffff);
            }
        }
    }
    bf16_t* Fm = (bf16_t*)(p.ws + OFF_FM);
    for (int it = blockIdx.x * NTHREADS + tid; it < 4096 * 256; it += gridDim.x * NTHREADS) {
        const int row = it >> 8, t0 = (it & 255) * 8, s = row & 2047, part = row >> 11;
        f32x4 a, b;
#pragma unroll
        for (int j = 0; j < 8; ++j) { float sn, cs; sincospif((float)((s * (t0 + j)) & 2047) / 1024.0f, &sn, &cs); const float v = (part ? sn : cs) * 0.022097086912079608f; if (j < 4) a[j] = v; else b[j - 4] = v; }
        *(u32x4*)(Fm + (size_t)row * 2048 + t0) = pack8(a, b);
    }
}

__device__ void ph_cvt(const float* __restrict__ x, bf16_t* __restrict__ H, float* __restrict__ SS, const int WID) {
    const int tid = opaque_tid(WID), lane = tid & 63, gw = blockIdx.x * 8 + __builtin_amdgcn_readfirstlane(tid >> 6);
    for (int row = gw * 2; row < CH; row += NWAVES_TOTAL * 2) {
        f32x4 v[2][8]; float ss[2] = {0.f, 0.f};
#pragma unroll
        for (int r = 0; r < 2; ++r)
#pragma unroll
            for (int i = 0; i < 8; ++i) v[r][i] = *(const f32x4*)(x + (size_t)(row + r) * DM + (i * 64 + lane) * 4);
#pragma unroll
        for (int r = 0; r < 2; ++r) {
#pragma unroll
            for (int i = 0; i < 8; ++i) ss[r] += v[r][i][0] * v[r][i][0] + v[r][i][1] * v[r][i][1] + v[r][i][2] * v[r][i][2] + v[r][i][3] * v[r][i][3];
#pragma unroll
            for (int o = 32; o >= 1; o >>= 1) ss[r] += __shfl_xor(ss[r], o);
#pragma unroll
            for (int i = 0; i < 8; ++i) { u32x2 w; w.x = cvt_pk_bf16(v[r][i][0], v[r][i][1]); w.y = cvt_pk_bf16(v[r][i][2], v[r][i][3]); *(u32x2*)(H + (size_t)(row + r) * DM + (i * 64 + lane) * 4) = w; }
            if (lane == 0) SS[row + r] = ss[r];
        }
    }
}
__device__ __forceinline__ void zero_rows(float* SS, const int WID) { for (int i = blockIdx.x * NTHREADS + opaque_tid(WID); i < CH; i += NBLOCKS * NTHREADS) SS[i] = 0.f; }

__device__ void ph_conv(const bf16_t* Z, bf16_t* X, const float* dw, const float* db, const float* lng, const float* lnb, int S, LAS unsigned char* lds_in, const int WID) {
    LAS unsigned char* lds = local_lds(lds_in);
    LAS bf16_t* ut = (LAS bf16_t*)lds;
    LAS float* yt = (LAS float*)(lds + 65536);
    const int tid = opaque_tid(WID), lane = tid & 63, wid = __builtin_amdgcn_readfirstlane(tid >> 6);
    float w[31];
#pragma unroll
    for (int j = 0; j < 31; ++j) w[j] = dw[j * 512 + tid];
    const float bias = db[tid];
    const f32x4 lg0 = *(const f32x4*)(lng + lane * 8), lg1 = *(const f32x4*)(lng + lane * 8 + 4), lb0 = *(const f32x4*)(lnb + lane * 8), lb1 = *(const f32x4*)(lnb + lane * 8 + 4);
    for (int tl = blockIdx.x; tl < CH / 32; tl += gridDim.x) {
        const int t0 = tl * 32, ss0 = (t0 / S) * S, se = ss0 + S;
        __syncthreads();
        {
            u32x4 aw[8], gw[8];
#pragma unroll
            for (int k = 0; k < 8; ++k) {
                const int idx = min(tid + k * NTHREADS, 62 * 64 - 1), rr = idx >> 6, c8 = (idx & 63) * 8, tok = min(max(t0 - 15 + rr, ss0), se - 1);
                aw[k] = *(const u32x4*)(Z + (size_t)tok * ZW + c8); gw[k] = *(const u32x4*)(Z + (size_t)tok * ZW + 512 + c8);
            }
#pragma unroll
            for (int k = 0; k < 8; ++k) {
                const int idx = tid + k * NTHREADS, rr = idx >> 6, c8 = (idx & 63) * 8, tok = t0 - 15 + rr;
                const float keep = (tok >= ss0 && tok < se) ? 1.0f : 0.0f;
                f32x4 a0, a1, g0, g1; unpack8(aw[k], a0, a1); unpack8(gw[k], g0, g1);
#pragma unroll
                for (int j = 0; j < 4; ++j) { a0[j] *= sigmoidf_(g0[j]) * keep; a1[j] *= sigmoidf_(g1[j]) * keep; }
                if (idx < 62 * 64) *(LAS u32x4*)(ut + rr * 512 + c8) = pack8(a0, a1);
            }
        }
        __syncthreads();
        for (int tt = 0; tt < 32; tt += 4) {
            float a0 = bias, a1 = bias, a2 = bias, a3 = bias;
#pragma unroll
            for (int jj = 0; jj < 34; ++jj) {
                const float xv = bf2f(ut[(tt + jj) * 512 + tid]);
                if (jj < 31) a0 += w[jj < 31 ? jj : 0] * xv;
                if (jj >= 1 && jj < 32) a1 += w[(jj >= 1 && jj < 32) ? jj - 1 : 0] * xv;
                if (jj >= 2 && jj < 33) a2 += w[(jj >= 2 && jj < 33) ? jj - 2 : 0] * xv;
                if (jj >= 3) a3 += w[jj >= 3 ? jj - 3 : 0] * xv;
            }
            yt[tt * 512 + tid] = a0; yt[(tt + 1) * 512 + tid] = a1; yt[(tt + 2) * 512 + tid] = a2; yt[(tt + 3) * 512 + tid] = a3;
        }
        __syncthreads();
#pragma unroll
        for (int q = 0; q < 4; ++q) {
            const int tt = wid * 4 + q;
            const f32x4 y0 = *(const LAS f32x4*)(yt + tt * 512 + lane * 8), y1 = *(const LAS f32x4*)(yt + tt * 512 + lane * 8 + 4);
            float s = (y0[0] + y0[1]) + (y0[2] + y0[3]) + (y1[0] + y1[1]) + (y1[2] + y1[3]);
#pragma unroll
            for (int o = 32; o >= 1; o >>= 1) s += __shfl_xor(s, o);
            const float mu = s * (1.0f / 512.0f);
            const f32x4 d0 = y0 - mu, d1 = y1 - mu;
            float qv = (d0[0] * d0[0] + d0[1] * d0[1]) + (d0[2] * d0[2] + d0[3] * d0[3]) + (d1[0] * d1[0] + d1[1] * d1[1]) + (d1[2] * d1[2] + d1[3] * d1[3]);
#pragma unroll
            for (int o = 32; o >= 1; o >>= 1) qv += __shfl_xor(qv, o);
            const float rstd = rsqrtf(qv * (1.0f / 512.0f) + EPS);
            f32x4 v0 = d0 * rstd * lg0 + lb0, v1 = d1 * rstd * lg1 + lb1;
#pragma unroll
            for (int j = 0; j < 4; ++j) { v0[j] *= sigmoidf_(v0[j]); v1[j] *= sigmoidf_(v1[j]); }
            *(u32x4*)(X + (size_t)(t0 + tt) * XW + 1024 + lane * 8) = pack8(v0, v1);
        }
    }
    __syncthreads();
}

__device__ void ph_qknorm(bf16_t* Z, const float* qg, const float* kg, const int WID) {
    const int tid = opaque_tid(WID), lane = tid & 63, gw = blockIdx.x * 8 + __builtin_amdgcn_readfirstlane(tid >> 6);
    f32x4 qgv[4], kgv[4];
#pragma unroll
    for (int e = 0; e < 4; ++e) { qgv[e] = *(const f32x4*)(qg + (lane & 7) * 16 + e * 4); kgv[e] = *(const f32x4*)(kg + (lane & 7) * 16 + e * 4); }
    for (int it0 = gw * 4; it0 < 2 * CH; it0 += NWAVES_TOTAL * 4) {
        u32x4 w0[4], w1[4];
#pragma unroll
        for (int q = 0; q < 4; ++q) { const int item = it0 + q; const bf16_t* ptr = Z + (size_t)(item >> 1) * ZW + ZQ + (item & 1) * 1024 + lane * 16; w0[q] = *(const u32x4*)ptr; w1[q] = *(const u32x4*)(ptr + 8); }
#pragma unroll
        for (int q = 0; q < 4; ++q) {
            const int item = it0 + q, isk = item & 1;
            bf16_t* ptr = Z + (size_t)(item >> 1) * ZW + ZQ + isk * 1024 + lane * 16;
            f32x4 a0, a1, a2, a3; unpack8(w0[q], a0, a1); unpack8(w1[q], a2, a3);
            float ss = 0.f;
#pragma unroll
            for (int j = 0; j < 4; ++j) ss += a0[j] * a0[j] + a1[j] * a1[j] + a2[j] * a2[j] + a3[j] * a3[j];
            ss += __shfl_xor(ss, 1); ss += __shfl_xor(ss, 2); ss += __shfl_xor(ss, 4);
            const float rstd = rsqrtf(ss * (1.0f / 128.0f) + EPS) * (isk ? 1.0f : 0.08838834764831845f);
            const f32x4 g0 = isk ? kgv[0] : qgv[0], g1 = isk ? kgv[1] : qgv[1], g2 = isk ? kgv[2] : qgv[2], g3 = isk ? kgv[3] : qgv[3];
            *(u32x4*)ptr = pack8(a0 * rstd * g0, a1 * rstd * g1); *(u32x4*)(ptr + 8) = pack8(a2 * rstd * g2, a3 * rstd * g3);
        }
    }
}

template <int SHIFT>
__device__ __forceinline__ void attn_pair(const bf16_t* Z, const bf16_t* TT, bf16_t* X, const LAS float* rp, int S, int b, int h, int r0, int rsA, int j, int lane, float kbound, float bmax, LAS u32x4* pl) {
    constexpr int NR = 8 + SHIFT;
    const int g = lane >> 4, n = lane & 15;
    const int kk0 = (n >> 2) * 8 + (n & 3);
    const int c0 = (j == 0) ? 0 : (j == 1) ? 8 : (j == 2) ? 24 : 32;
    const int tokq = b * S + r0 * 64 + j * 16 + n;
    const int tok0 = b * S + rsA * 64 + c0;
    const char* qU = (const char*)Z + ((size_t)(b * S + r0 * 64 + j * 16) * ZW + ZQ + h * 128) * 2; const unsigned qL = (unsigned)(n * ZW + g * 8) * 2u;
    const char* kU = (const char*)Z + ((size_t)tok0 * ZW + ZK + h * 128) * 2; const unsigned kL = (unsigned)(kk0 * ZW + g * 8) * 2u;
    const char* vU = (const char*)TT + ((size_t)(512 + h * 128) * CH + tok0) * 2; const unsigned vL = (unsigned)(n * CH + g * 8) * 2u;
    bf16x8 qA[4], qB[4];
#pragma unroll
    for (int ks = 0; ks < 4; ++ks) { qA[ks] = *(const bf16x8*)(qU + ks * 64 + qL); qB[ks] = *(const bf16x8*)(qU + (size_t)64 * ZW * 2 + ks * 64 + qL); }
    bf16x8 kf[2][8];
#define ATT_LOADK(buf, i) do { const char* _k = kU + (size_t)(i) * 64 * ZW * 2; _Pragma("unroll") for (int ks = 0; ks < 4; ++ks) { kf[buf][ks] = *(const bf16x8*)(_k + ks * 64 + kL); kf[buf][4 + ks] = *(const bf16x8*)(_k + (size_t)4 * ZW * 2 + ks * 64 + kL); } } while (0)
    ATT_LOADK(0, 0); ATT_LOADK(1, 1);
    float ssA = 0.f, ssB = 0.f;
#pragma unroll
    for (int ks = 0; ks < 4; ++ks) { u32x4 wa, wb; __builtin_memcpy(&wa, &qA[ks], 16); __builtin_memcpy(&wb, &qB[ks], 16); f32x4 a0, a1, b0, b1; unpack8(wa, a0, a1); unpack8(wb, b0, b1);
#pragma unroll
        for (int e = 0; e < 4; ++e) { ssA += a0[e] * a0[e] + a1[e] * a1[e]; ssB += b0[e] * b0[e] + b1[e] * b1[e]; } }
    ssA += __shfl_xor(ssA, 16); ssA += __shfl_xor(ssA, 32); ssB += __shfl_xor(ssB, 16); ssB += __shfl_xor(ssB, 32);
    const float CA = sqrtf(ssA) * kbound + bmax, CB = sqrtf(ssB) * kbound + bmax;
    const int c = j * 16 + n, start = min(max(c - 8, 0), 48);
    float lA = 0.f, lB = 0.f;
#define ATT_SCORE(QF, CC, DR, PDST, LSUM) do { \
        f32x4 s0 = {0.f, 0.f, 0.f, 0.f}, s1 = s0; \
        _Pragma("unroll") for (int ks = 0; ks < 4; ++ks) { s0 = __builtin_amdgcn_mfma_f32_16x16x32_bf16(kf[i % 2][ks], QF[ks], s0, 0, 0, 0); s1 = __builtin_amdgcn_mfma_f32_16x16x32_bf16(kf[i % 2][4 + ks], QF[ks], s1, 0, 0, 0); } \
        const LAS float* bp = rp + (h * 15 + (DR)) * 31; \
        _Pragma("unroll") for (int jj = 0; jj < 4; ++jj) { \
            const int kc0 = c0 + g * 8 + jj, kc1 = kc0 + 4; \
            const bool v0 = (kc0 >= start) && (kc0 < start + 16), v1 = (kc1 >= start) && (kc1 < start + 16); \
            const float p0 = v0 ? __expf(s0[jj] + bp[min(max(kc0 - c + 15, 0), 30)] - (CC)) : 0.f; \
            const float p1 = v1 ? __expf(s1[jj] + bp[min(max(kc1 - c + 15, 0), 30)] - (CC)) : 0.f; \
            s0[jj] = p0; s1[jj] = p1; LSUM += p0 + p1; } \
        pl[(PDST) * 64] = pack8(s0, s1); } while (0)
#pragma unroll
    for (int i = 0; i < NR; ++i) {
        if (i < 8) ATT_SCORE(qA, CA, (rsA + i) - r0 + 7, i, lA);
        __builtin_amdgcn_sched_barrier(0);
        if (i >= SHIFT && i - SHIFT < 8) ATT_SCORE(qB, CB, (rsA + i) - (r0 + 1) + 7, 8 + i - SHIFT, lB);
        __builtin_amdgcn_sched_barrier(0);
        if (i + 2 < NR) ATT_LOADK(i % 2, i + 2);
        asm volatile("" ::: "memory"); __builtin_amdgcn_sched_barrier(0);
    }
#undef ATT_SCORE
#undef ATT_LOADK
    bf16x8 vf[2][8];
#define ATT_LOADV(buf, i) do { const char* _v = vU + (i) * 128; _Pragma("unroll") for (int dt = 0; dt < 8; ++dt) vf[buf][dt] = *(const bf16x8*)(_v + (size_t)dt * 16 * CH * 2 + vL); } while (0)
    ATT_LOADV(0, 0); ATT_LOADV(1, 1);
    lA += __shfl_xor(lA, 16); lA += __shfl_xor(lA, 32); lB += __shfl_xor(lB, 16); lB += __shfl_xor(lB, 32);
    const float invA = 1.0f / lA, invB = 1.0f / lB;
    f32x4 oA[8], oB[8];
#pragma unroll
    for (int dt = 0; dt < 8; ++dt) { oA[dt] = (f32x4){0.f, 0.f, 0.f, 0.f}; oB[dt] = (f32x4){0.f, 0.f, 0.f, 0.f}; }
#pragma unroll
    for (int i = 0; i < NR; ++i) {
        if (i < 8) { const u32x4 pw = pl[i * 64]; bf16x8 pb; __builtin_memcpy(&pb, &pw, 16);
#pragma unroll
            for (int dt = 0; dt < 8; ++dt) oA[dt] = __builtin_amdgcn_mfma_f32_16x16x32_bf16(vf[i % 2][dt], pb, oA[dt], 0, 0, 0); }
        if (i >= SHIFT && i - SHIFT < 8) { const u32x4 pw = pl[(8 + i - SHIFT) * 64]; bf16x8 pb; __builtin_memcpy(&pb, &pw, 16);
#pragma unroll
            for (int dt = 0; dt < 8; ++dt) oB[dt] = __builtin_amdgcn_mfma_f32_16x16x32_bf16(vf[i % 2][dt], pb, oB[dt], 0, 0, 0); }
        __builtin_amdgcn_sched_barrier(0);
        if (i + 2 < NR) ATT_LOADV(i % 2, i + 2);
        asm volatile("" ::: "memory"); __builtin_amdgcn_sched_barrier(0);
    }
#undef ATT_LOADV
    bf16_t* op = X + (size_t)tokq * XW + 1536 + h * 128 + g * 4;
#pragma unroll
    for (int dt = 0; dt < 8; ++dt) {
        u32x2 w; w.x = cvt_pk_bf16(oA[dt][0] * invA, oA[dt][1] * invA); w.y = cvt_pk_bf16(oA[dt][2] * invA, oA[dt][3] * invA); *(u32x2*)(op + dt * 16) = w;
        u32x2 v; v.x = cvt_pk_bf16(oB[dt][0] * invB, oB[dt][1] * invB); v.y = cvt_pk_bf16(oB[dt][2] * invB, oB[dt][3] * invB); *(u32x2*)(op + (size_t)64 * XW + dt * 16) = v;
    }
}
__device__ void ph_attn(const bf16_t* Z, const bf16_t* TT, bf16_t* X, const float* rpb, const float* kg, int S, int rows, int nb, LAS unsigned char* lds_in, const int WID) {
    LAS unsigned char* lds = local_lds(lds_in);
    const int tid = opaque_tid(WID), lane = tid & 63;
    LAS float* rp = (LAS float*)lds;
    __syncthreads();
    for (int i = tid; i < 8 * 15 * 31; i += NTHREADS) rp[i] = rpb[i];
    __syncthreads();
    float bmax = 0.f;
    for (int i = lane; i < 8 * 15 * 31; i += 64) bmax = fmaxf(bmax, fabsf(rp[i]));
    float gmax = fmaxf(fabsf(kg[lane]), fabsf(kg[lane + 64]));
#pragma unroll
    for (int o = 32; o >= 1; o >>= 1) { bmax = fmaxf(bmax, __shfl_xor(bmax, o)); gmax = fmaxf(gmax, __shfl_xor(gmax, o)); }
    const float kbound = gmax * 11.313708499f * 1.01f;
    const int vblk = (blockIdx.x & 7) * (NBLOCKS / 8) + (blockIdx.x >> 3);
    const int gw = vblk * 8 + __builtin_amdgcn_readfirstlane(tid >> 6);
    LAS u32x4* pl = (LAS u32x4*)(lds + 15360) + __builtin_amdgcn_readfirstlane(tid >> 6) * (16 * 64) + lane;
    const int hrows = rows >> 1, total = nb * 8 * hrows * 4;
    for (int u = gw; u < total; u += NWAVES_TOTAL) {
        const int j = u & 3, rr = u >> 2, rpi = rr % hrows, bh = rr / hrows, h = bh & 7, b = bh >> 3;
        const int r0 = 2 * rpi, rsA = min(max(r0 - 4, 0), rows - 8), rsB = min(max(r0 - 3, 0), rows - 8);
        if (rsB != rsA) attn_pair<1>(Z, TT, X, rp, S, b, h, r0, rsA, j, lane, kbound, bmax, pl);
        else attn_pair<0>(Z, TT, X, rp, S, b, h, r0, rsA, j, lane, kbound, bmax, pl);
    }
}

__device__ void ph_combine(const bf16_t* E, bf16_t* X, const int WID) {
    const int tid = opaque_tid(WID), lane = tid & 63, gw = blockIdx.x * 8 + __builtin_amdgcn_readfirstlane(tid >> 6);
    const int gq = lane >> 4, c8 = (lane & 15) * 8;
    for (int item = gw; item < CH; item += NWAVES_TOTAL) {
        const int b = item >> 13, k = item & 8191, m = k & 2047;
        f32x4 xc0 = {0.f, 0.f, 0.f, 0.f}, xc1 = xc0, xs0 = xc0, xs1 = xc0;
#pragma unroll
        for (int r = 0; r < 4; ++r) {
            float sn, cs; sincospif((float)((r * k) & 8191) / 4096.0f, &sn, &cs);
            const bf16_t* ep = E + (size_t)((b * 4 + r) * 2048 + m) * 1024 + gq * 256 + c8;
            const u32x4 cw = *(const u32x4*)ep, sw = *(const u32x4*)(ep + 128);
            f32x4 ec0, ec1, es0, es1; unpack8(cw, ec0, ec1); unpack8(sw, es0, es1);
            xc0 += cs * ec0 - sn * es0; xc1 += cs * ec1 - sn * es1;
            xs0 += cs * es0 + sn * ec0; xs1 += cs * es1 + sn * ec1;
        }
        bf16_t* xp = X + (size_t)item * XW + gq * 256 + c8;
        *(u32x4*)xp = pack8(xc0 * 0.5f, xc1 * 0.5f); *(u32x4*)(xp + 128) = pack8(xs0 * 0.5f, xs1 * 0.5f);
    }
}


#define XB_TMO      128
#define XB_XCNT(j)  (256  + 64 * (j))
#define XB_XSUB(j)  (1280 + 64 * (j))
#define XB_XGEN(j)  (2304 + 64 * (j))
#define XB_TOP      3328
#define XB_TOPGEN   3392
#define XCD_BAR_WORDS 3456
#define XB_SPIN_CAP (1u << 20)
__device__ __forceinline__ unsigned xb_ld(unsigned* p)              { return __hip_atomic_load(p, __ATOMIC_RELAXED, __HIP_MEMORY_SCOPE_AGENT); }
__device__ __forceinline__ unsigned xb_add(unsigned* p, unsigned v) { return __hip_atomic_fetch_add(p, v, __ATOMIC_RELAXED, __HIP_MEMORY_SCOPE_AGENT); }
__device__ __forceinline__ unsigned xb_xcc_id() { return (unsigned)__builtin_amdgcn_s_getreg((3 << 11) | 20) & 0xFu; }
#define XB_SPIN(cond, bar) do { unsigned _sp = 0; while (cond) { __builtin_amdgcn_s_sleep(1); \
    if ((++_sp & 255u) == 0u) { if (xb_ld(&(bar)[XB_TMO])) break; if (_sp > XB_SPIN_CAP) { atomicAdd(&(bar)[XB_TMO], 1u); break; } } } } while (0)
struct XcdBarrier { unsigned* bar; unsigned x; volatile LAS unsigned* st; };
__device__ __forceinline__ XcdBarrier xcd_barrier_post(unsigned* bar, volatile LAS unsigned* st) {
    XcdBarrier b; b.bar = bar; b.x = xb_xcc_id(); b.st = st;
    if (threadIdx.x == 0) (void)xb_add(&bar[XB_XCNT(b.x)], 1u);
    return b;
}
__device__ __forceinline__ void xcd_barrier_complete(unsigned* bar, unsigned x, unsigned& nloc, unsigned& nx) {
    const unsigned G = gridDim.x * gridDim.y * gridDim.z;
    unsigned sum, cnt, mine, sp = 0u;
    for (;;) {
        sum = 0u; cnt = 0u; mine = 0u;
#pragma unroll
        for (unsigned j = 0; j < 16; ++j) { const unsigned c = xb_ld(&bar[XB_XCNT(j)]); sum += c; cnt += (c > 0u) ? 1u : 0u; }
        mine = xb_ld(&bar[XB_XCNT(x)]);
        if (sum == G) break;
        __builtin_amdgcn_s_sleep(1);
        if ((++sp & 255u) == 0u) { if (xb_ld(&bar[XB_TMO])) break; if (sp > XB_SPIN_CAP) { atomicAdd(&bar[XB_TMO], 1u); break; } }
    }
    nloc = mine > 0u ? mine : 1u; nx = cnt > 0u ? cnt : 1u;
}
__device__ __forceinline__ void xcd_barrier(const XcdBarrier& b, const int WID) {
    asm volatile("s_waitcnt vmcnt(0)" ::: "memory");
    __syncthreads();
    if (opaque_tid(WID) == 0) {
        unsigned* bar = b.bar; asm volatile("" : "+s"(bar));
        __builtin_amdgcn_s_waitcnt(0);
        unsigned nloc = b.st[0], nx = b.st[1];
        if (nloc == 0u) { xcd_barrier_complete(bar, b.x, nloc, nx); b.st[0] = nloc; b.st[1] = nx; }
        const unsigned old = xb_add(&bar[XB_XSUB(b.x)], 1u);
        const unsigned gen = old / nloc;
        if (old + 1u == (gen + 1u) * nloc) {
            __builtin_amdgcn_fence(__ATOMIC_RELEASE, "agent");
            asm volatile("s_waitcnt vmcnt(0)" ::: "memory");
            const unsigned og = xb_add(&bar[XB_TOP], 1u);
            const unsigned tg = og / nx;
            if (og + 1u == (tg + 1u) * nx) xb_add(&bar[XB_TOPGEN], 1u);
            else XB_SPIN(xb_ld(&bar[XB_TOPGEN]) == tg, bar);
            __builtin_amdgcn_fence(__ATOMIC_ACQUIRE, "agent");
            xb_add(&bar[XB_XGEN(b.x)], 1u);
            asm volatile("s_waitcnt vmcnt(0)" ::: "memory");
        } else {
            XB_SPIN(xb_ld(&bar[XB_XGEN(b.x)]) == gen, bar);
            __builtin_amdgcn_fence(__ATOMIC_ACQUIRE, "agent");
            asm volatile("s_waitcnt vmcnt(0)" ::: "memory");
        }
    }
    __syncthreads();
}

constexpr int STEPS = 15;
constexpr int N_PHASES = 1 + NCHUNK * STEPS;

__global__ void __launch_bounds__(NTHREADS, 2) fwd_kernel(Params p) {
    extern __shared__ __attribute__((aligned(16))) unsigned char lds_raw[];
    LAS unsigned char* lds = (LAS unsigned char*)lds_raw;
    const int G = gridDim.x, cblk = blockIdx.x;
    const int WID = __builtin_amdgcn_readfirstlane((int)threadIdx.x >> 6);
    if (threadIdx.x < 4) ((LAS unsigned*)(lds + LDS_BAR_OFF))[threadIdx.x] = 0u;
    __syncthreads();
    const XcdBarrier xbar = xcd_barrier_post((unsigned*)(p.ws + OFF_BAR), (volatile LAS unsigned*)(lds + LDS_BAR_OFF));
    unsigned char* ws = p.ws;
    bf16_t* Fm = (bf16_t*)(ws + OFF_FM); bf16_t* H = (bf16_t*)(ws + OFF_H); bf16_t* Z = (bf16_t*)(ws + OFF_Z); bf16_t* HID = Z;
    bf16_t* TT = (bf16_t*)(ws + OFF_TT); bf16_t* E = (bf16_t*)(ws + OFF_E); bf16_t* X = (bf16_t*)(ws + OFF_X); bf16_t* M = (bf16_t*)(ws + OFF_M);
    ph_prep(p, lds, WID);
    asm volatile("" ::: "memory");
    cg::this_grid().sync();
    for (int phi = 1; phi < N_PHASES; ++phi) {
        int ph = phi, cb = cblk, Gv = G; asm volatile("" : "+s"(ph), "+s"(cb), "+s"(Gv));
        {
            const int q = ph - 1, chunk = q / STEPS, step = q % STEPS, layer = step >= 8 ? 1 : 0, sub = step == 0 ? 0 : (step - 1) % 7 + 1;
            const int sample = chunk == 2, S = sample ? 8192 : 2048, rows = S / 64, nb = CH / S;
            const unsigned char* wl = ws + OFF_W + (size_t)layer * SZ_LAYER;
            const char* WinT = (const char*)wl; const char* W1T = (const char*)(wl + SZ_WIN); const char* W2T = (const char*)(wl + SZ_WIN + SZ_W1);
            const char* WoT = (const char*)(wl + SZ_WIN + SZ_W1 + SZ_W2); const char* WcT = (const char*)(wl + SZ_WIN + SZ_W1 + SZ_W2 + SZ_WO);
            float* xout = p.out + (size_t)chunk * CH * DM;
            const float* xin = layer == 0 ? (sample ? p.in[1] : p.in[0] + (size_t)chunk * CH * DM) : xout;
            float* SS1 = (float*)(ws + OFF_SS1); float* SS2 = (float*)(ws + OFF_SS2);
            switch (sub) {
            case 0: ph_cvt(xin, H, SS1, WID); break;
            case 1: { zero_rows(SS2, WID); SchedB Sc{(const char*)H, WinT, Gv, cb}; EpiB Ep{Z, TT, p.in[4] + layer * 6144, SS1, sample}; pg8::gemm_phase(lds, 2048, 2048, Sc, Ep, WID); } break;
            case 2: { SchedDFT Sc{(const char*)Fm, (const char*)TT, Gv, cb}; EpiDFT Ep{X, E, sample}; pg8::gemm_phase(lds, 2048, CH, Sc, Ep, WID);
                      __syncthreads();
                      ph_conv(Z, X, p.in[6] + layer * 31 * 512, p.in[7] + layer * 512, p.in[8] + layer * 512, p.in[9] + layer * 512, S, lds, WID);
                      ph_qknorm(Z, p.in[11] + layer * 128, p.in[12] + layer * 128, WID); } break;
            case 3: { int reps = (PROBE_DUP == 3) ? 2 : 1; asm volatile("" : "+s"(reps)); for (int rep = 0; rep < reps; ++rep) { ph_attn(Z, TT, X, p.in[13] + layer * 8 * 15 * 31, p.in[12] + layer * 128, S, rows, nb, lds, WID); if (sample) ph_combine(E, X, WID); asm volatile("" ::: "memory"); } } break;
            case 4: { SchedPlain Sc{(const char*)X, WcT, 64, 8, XW, XW, 40, Gv, cb, 4}; EpiMrg2 Ep{Z, M}; pg8::gemm_phase(lds, XW, XW, Sc, Ep, WID); } break;
            case 5: { zero_rows(SS1, WID); SchedPlain Sc{(const char*)M, WoT, 64, 8, 2048, 2048, 32, Gv, cb, 4}; EpiRes Ep{H, (float*)nullptr, SS2}; pg8::gemm_phase(lds, 2048, 2048, Sc, Ep, WID); } break;
            case 6: { SchedPlain Sc{(const char*)H, W1T, 64, 32, 2048, 2048, 32, Gv, cb, 4}; EpiRelu2 Ep{HID, SS2}; pg8::gemm_phase(lds, 2048, 2048, Sc, Ep, WID); } break;
            case 7: { SchedPlain Sc{(const char*)HID, W2T, 64, 8, 8192, 8192, 128, Gv, cb, 4}; EpiRes Ep{H, layer == 0 ? (float*)nullptr : xout, SS1}; pg8::gemm_phase(lds, 8192, 8192, Sc, Ep, WID); } break;
            }
        }
        asm volatile("" ::: "memory");
        if (phi + 1 < N_PHASES) { xcd_barrier(xbar, WID); for (int e = 0; e < PROBE_SYNCS; ++e) xcd_barrier(xbar, WID); }
    }
}

extern "C" void kernel_launch(void* const* d_in, const int* in_sizes, int n_in, void* d_out, int out_size, void* d_ws, size_t ws_size, hipStream_t stream) {
    static int ready = 0;
    if (!ready) {
        if (n_in != 19 || ws_size < WS_END) { fprintf(stderr, "kernel_launch: unexpected n_in %d / ws_size %zu (need %zu)\n", n_in, ws_size, (size_t)WS_END); ready = -1; return; }
        if (hipFuncSetAttribute((const void*)fwd_kernel, hipFuncAttributeMaxDynamicSharedMemorySize, LDS_BYTES) != hipSuccess) { fprintf(stderr, "kernel_launch: hipFuncSetAttribute failed\n"); ready = -1; return; }
        int per_cu = 0;
        if (hipOccupancyMaxActiveBlocksPerMultiprocessor(&per_cu, (const void*)fwd_kernel, NTHREADS, LDS_BYTES) != hipSuccess || per_cu < 1) fprintf(stderr, "kernel_launch: occupancy query says %d blocks per CU\n", per_cu);
        (void)hipGetLastError();
        ready = 1;
    }
    if (ready < 0) return;
    if (hipMemsetAsync((char*)d_ws + OFF_BAR, 0, BAR_BYTES, stream) != hipSuccess) { fprintf(stderr, "kernel_launch: memset failed\n"); return; }
    Params p{};
    for (int i = 0; i < 19; ++i) p.in[i] = (const float*)d_in[i];
    p.out = (float*)d_out; p.ws = (unsigned char*)d_ws;
#if MODE_MULTI
    for (int ph = 0; ph < N_PHASES; ++ph) { p.ph_lo = ph; p.ph_hi = ph + 1; hipLaunchKernelGGL(fwd_kernel, dim3(NBLOCKS), dim3(NTHREADS), LDS_BYTES, stream, p); }
#else
    p.ph_lo = 0; p.ph_hi = N_PHASES;
    void* args[] = {&p};
    hipError_t e = hipLaunchCooperativeKernel((const void*)fwd_kernel, dim3(NBLOCKS), dim3(NTHREADS), args, LDS_BYTES, stream);
    if (e != hipSuccess) fprintf(stderr, "cooperative launch failed: %s\n", hipGetErrorString(e));
#endif
}
```
